# Optimizing an MI355X kernel written in HIP

```python
import math
import jax, jax.numpy as jnp
from jax import lax
import numpy as np

D_MODEL = 2048
BATCH = 4
SEQ = 4096
DEPTH = 2

CONV_WIDTH = D_MODEL // 2
CONV_K = 3
MLA_V = 128
MLA_HEADS = (D_MODEL // 2) // MLA_V
MLA_NOPE = 128
MLA_ROPE = 64
MLA_Q_RANK = D_MODEL // 4
MLA_KV_RANK = D_MODEL // 8
ROPE_THETA = 10000.0
EVEN_IN_WIDTH = 3 * CONV_WIDTH + MLA_Q_RANK + MLA_KV_RANK + MLA_ROPE
EVEN_SPLITS = (CONV_WIDTH, 2 * CONV_WIDTH, 3 * CONV_WIDTH,
               3 * CONV_WIDTH + MLA_Q_RANK, 3 * CONV_WIDTH + MLA_Q_RANK + MLA_KV_RANK)
EVEN_MIX_WIDTH = CONV_WIDTH + MLA_HEADS * MLA_V
DIFF_HEAD_DIM = 128
DIFF_HEADS = D_MODEL // (2 * DIFF_HEAD_DIM)
N_GROUPS = 4
EXPERTS_PER_GROUP = 8
N_EXPERTS = N_GROUPS * EXPERTS_PER_GROUP
EXPERT_FF = D_MODEL // 4
TOP_K = 2

Q_BLOCK = 128
NORM_EPS = 1e-6

kernel_name = "hybrid_shortconv_mla_diffattn_hmoe"


def _rms_norm(x, g):
    xf = x.astype(jnp.float32)
    y = xf * lax.rsqrt(jnp.mean(xf * xf, axis=-1, keepdims=True) + NORM_EPS)
    return (y * g.astype(jnp.float32)).astype(x.dtype)


def _to_blocks(t):
    b, s = t.shape[:2]
    return jnp.moveaxis(t.reshape((b, s // Q_BLOCK, Q_BLOCK) + t.shape[2:]), 1, 0)


def _from_blocks(t):
    t = jnp.moveaxis(t, 0, 1)
    return t.reshape((t.shape[0], t.shape[1] * t.shape[2]) + t.shape[3:])


def _rope_tables(s):
    pos = jnp.arange(s, dtype=jnp.float32)
    inv_freq = ROPE_THETA ** (-jnp.arange(0, MLA_ROPE, 2, dtype=jnp.float32) / MLA_ROPE)
    ang = pos[:, None] * inv_freq[None, :]
    return jnp.cos(ang), jnp.sin(ang)


def _rope(t, cos, sin):
    t1, t2 = jnp.split(t.astype(jnp.float32), 2, axis=-1)
    return jnp.concatenate([t1 * cos - t2 * sin, t1 * sin + t2 * cos], axis=-1).astype(t.dtype)


def _alibi_slopes(n):
    return (2.0 ** (-8.0 * np.arange(1, n + 1) / n)).astype(np.float32)


def _causal_depthwise_conv(u, w):
    return lax.conv_general_dilated(
        u, w[:, None, :].astype(u.dtype), window_strides=(1,), padding=[(CONV_K - 1, 0)],
        dimension_numbers=("NWC", "WIO", "NWC"), feature_group_count=u.shape[-1])


def _mla_attention(q_nope, q_rope, k_nope, k_rope, v):
    s = q_nope.shape[1]
    scale = (MLA_NOPE + MLA_ROPE) ** -0.5
    k_pos = jnp.arange(s)

    def block(args):
        qn, qr, i = args
        q_pos = i * Q_BLOCK + jnp.arange(Q_BLOCK)
        scores = (jnp.einsum("bqhd,bkhd->bhqk", qn, k_nope)
                  + jnp.einsum("bqhr,bkr->bhqk", qr, k_rope)).astype(jnp.float32) * scale
        scores = jnp.where(k_pos[None, :] <= q_pos[:, None], scores, -jnp.inf)
        p = jax.nn.softmax(scores, axis=-1).astype(v.dtype)
        return jnp.einsum("bhqk,bkhe->bqhe", p, v)

    out = lax.map(block, (_to_blocks(q_nope), _to_blocks(q_rope), jnp.arange(s // Q_BLOCK)))
    return _from_blocks(out)


def _diff_attention(q, k, v, lam):
    s = q.shape[1]
    scale = DIFF_HEAD_DIM ** -0.5
    slopes = jnp.asarray(_alibi_slopes(DIFF_HEADS))
    k_pos = jnp.arange(s)

    def block(args):
        qb, i = args
        q_pos = i * Q_BLOCK + jnp.arange(Q_BLOCK)
        dist = (q_pos[:, None] - k_pos[None, :]).astype(jnp.float32)
        bias = -slopes[:, None, None] * dist
        scores = jnp.einsum("bqhjd,bkhjd->bhjqk", qb, k).astype(jnp.float32) * scale + bias[None, :, None]
        scores = jnp.where(dist >= 0.0, scores, -jnp.inf)
        p = jax.nn.softmax(scores, axis=-1)
        a = p[:, :, 0] - lam * p[:, :, 1]
        return jnp.einsum("bhqk,bkhe->bqhe", a.astype(v.dtype), v)

    out = lax.map(block, (_to_blocks(q), jnp.arange(s // Q_BLOCK)))
    return _from_blocks(out)


def _even_mixer(x, g_mix, w_in, conv_w, g_q_lat, w_uq, g_kv_lat, w_ukv, w_out):
    b, s, _ = x.shape
    h = _rms_norm(x, g_mix)
    gate_b, gate_c, u, c_q, c_kv, k_r = jnp.split(h @ w_in, EVEN_SPLITS, axis=-1)
    y_conv = gate_b * _causal_depthwise_conv(gate_c * u, conv_w)
    cos, sin = _rope_tables(s)
    q = (_rms_norm(c_q, g_q_lat) @ w_uq).reshape(b, s, MLA_HEADS, MLA_NOPE + MLA_ROPE)
    q_nope = q[..., :MLA_NOPE]
    q_rope = _rope(q[..., MLA_NOPE:], cos[:, None, :], sin[:, None, :])
    kv = (_rms_norm(c_kv, g_kv_lat) @ w_ukv).reshape(b, s, MLA_HEADS, MLA_NOPE + MLA_V)
    k_nope, v = kv[..., :MLA_NOPE], kv[..., MLA_NOPE:]
    k_rope = _rope(k_r, cos, sin)
    y_mla = _mla_attention(q_nope, q_rope, k_nope, k_rope, v).reshape(b, s, MLA_HEADS * MLA_V)
    return jnp.concatenate([y_conv, y_mla], axis=-1) @ w_out


def _odd_mixer(x, g_mix, w_qkv, lam_q1, lam_k1, lam_q2, lam_k2, g_subln, w_out, layer_idx):
    b, s, _ = x.shape
    h = _rms_norm(x, g_mix)
    q, k, v = jnp.split(h @ w_qkv, 3, axis=-1)
    q = q.reshape(b, s, DIFF_HEADS, 2, DIFF_HEAD_DIM)
    k = k.reshape(b, s, DIFF_HEADS, 2, DIFF_HEAD_DIM)
    v = v.reshape(b, s, DIFF_HEADS, 2 * DIFF_HEAD_DIM)
    lam_init = 0.8 - 0.6 * math.exp(-0.3 * layer_idx)
    f32 = jnp.float32
    lam = (jnp.exp(jnp.sum(lam_q1.astype(f32) * lam_k1.astype(f32)))
           - jnp.exp(jnp.sum(lam_q2.astype(f32) * lam_k2.astype(f32))) + lam_init)
    o = _diff_attention(q, k, v, lam)
    o = _rms_norm(o, g_subln) * (1.0 - lam_init)
    return o.reshape(b, s, DIFF_HEADS * 2 * DIFF_HEAD_DIM) @ w_out


def _hier_moe(h, w_group, b_group, w_expert, b_expert, w_up_gate, w_down):
    b, s, d = h.shape
    t = h.reshape(b * s, d)
    g_probs = jax.nn.softmax((t @ w_group + b_group).astype(jnp.float32), axis=-1)
    g_prob, g_idx = lax.top_k(g_probs, 1)
    e_logits = (t @ w_expert + b_expert).astype(jnp.float32).reshape(-1, N_GROUPS, EXPERTS_PER_GROUP)
    e_logits = jnp.take_along_axis(e_logits, g_idx[:, :, None], axis=1)[:, 0]
    top_logits, e_idx = lax.top_k(e_logits, TOP_K)
    weights = g_prob * jax.nn.softmax(top_logits, axis=-1)
    expert_id = g_idx * EXPERTS_PER_GROUP + e_idx
    combine = jnp.sum(jax.nn.one_hot(expert_id, N_EXPERTS, dtype=jnp.float32) * weights[..., None], axis=1)
    combine = combine.astype(t.dtype)
    out = jnp.zeros_like(t)
    for e in range(N_EXPERTS):
        gate, up = jnp.split(t @ w_up_gate[e], 2, axis=-1)
        out = out + combine[:, e:e + 1] * ((jax.nn.silu(gate) * up) @ w_down[e])
    return out.reshape(b, s, d)


def setup_inputs(seed: int = 0) -> dict:
    key = jax.random.key(seed)
    ks = iter(jax.random.split(key, 40))

    def w(shape, fan_in):
        return jax.random.normal(next(ks), shape, jnp.float32) * fan_in ** -0.5

    def gain(n):
        return 1.0 + 0.01 * jax.random.normal(next(ks), (n,), jnp.float32)

    def small(shape, scale):
        return scale * jax.random.normal(next(ks), shape, jnp.float32)

    inp = {}
    inp["x"] = jax.random.normal(next(ks), (BATCH, SEQ, D_MODEL), jnp.float32)
    inp["l0_g_mix"] = gain(D_MODEL)
    inp["l0_w_in"] = w((D_MODEL, EVEN_IN_WIDTH), D_MODEL)
    inp["l0_conv_w"] = w((CONV_K, CONV_WIDTH), CONV_K)
    inp["l0_g_q_lat"] = gain(MLA_Q_RANK)
    inp["l0_w_uq"] = w((MLA_Q_RANK, MLA_HEADS * (MLA_NOPE + MLA_ROPE)), MLA_Q_RANK)
    inp["l0_g_kv_lat"] = gain(MLA_KV_RANK)
    inp["l0_w_ukv"] = w((MLA_KV_RANK, MLA_HEADS * (MLA_NOPE + MLA_V)), MLA_KV_RANK)
    inp["l0_w_out"] = w((EVEN_MIX_WIDTH, D_MODEL), EVEN_MIX_WIDTH)
    inp["l0_g_ffn"] = gain(D_MODEL)
    inp["l0_w_group"] = w((D_MODEL, N_GROUPS), D_MODEL)
    inp["l0_b_group"] = small((N_GROUPS,), 0.01)
    inp["l0_w_expert"] = w((D_MODEL, N_EXPERTS), D_MODEL)
    inp["l0_b_expert"] = small((N_EXPERTS,), 0.01)
    inp["l0_w_up_gate"] = w((N_EXPERTS, D_MODEL, 2 * EXPERT_FF), D_MODEL)
    inp["l0_w_down"] = w((N_EXPERTS, EXPERT_FF, D_MODEL), EXPERT_FF)
    inp["l1_g_mix"] = gain(D_MODEL)
    inp["l1_w_qkv"] = w((D_MODEL, 3 * D_MODEL), D_MODEL)
    inp["l1_lam_q1"] = small((DIFF_HEAD_DIM,), 0.1)
    inp["l1_lam_k1"] = small((DIFF_HEAD_DIM,), 0.1)
    inp["l1_lam_q2"] = small((DIFF_HEAD_DIM,), 0.1)
    inp["l1_lam_k2"] = small((DIFF_HEAD_DIM,), 0.1)
    inp["l1_g_subln"] = gain(2 * DIFF_HEAD_DIM)
    inp["l1_w_out"] = w((DIFF_HEADS * 2 * DIFF_HEAD_DIM, D_MODEL), DIFF_HEADS * 2 * DIFF_HEAD_DIM)
    inp["l1_g_ffn"] = gain(D_MODEL)
    inp["l1_w_group"] = w((D_MODEL, N_GROUPS), D_MODEL)
    inp["l1_b_group"] = small((N_GROUPS,), 0.01)
    inp["l1_w_expert"] = w((D_MODEL, N_EXPERTS), D_MODEL)
    inp["l1_b_expert"] = small((N_EXPERTS,), 0.01)
    inp["l1_w_up_gate"] = w((N_EXPERTS, D_MODEL, 2 * EXPERT_FF), D_MODEL)
    inp["l1_w_down"] = w((N_EXPERTS, EXPERT_FF, D_MODEL), EXPERT_FF)
    inp["g_final"] = gain(D_MODEL)
    return inp


def reference(x,
              l0_g_mix, l0_w_in, l0_conv_w, l0_g_q_lat, l0_w_uq, l0_g_kv_lat, l0_w_ukv, l0_w_out,
              l0_g_ffn, l0_w_group, l0_b_group, l0_w_expert, l0_b_expert, l0_w_up_gate, l0_w_down,
              l1_g_mix, l1_w_qkv, l1_lam_q1, l1_lam_k1, l1_lam_q2, l1_lam_k2, l1_g_subln, l1_w_out,
              l1_g_ffn, l1_w_group, l1_b_group, l1_w_expert, l1_b_expert, l1_w_up_gate, l1_w_down,
              g_final):
    even_params = ((l0_g_mix, l0_w_in, l0_conv_w, l0_g_q_lat, l0_w_uq, l0_g_kv_lat, l0_w_ukv, l0_w_out),)
    odd_params = ((l1_g_mix, l1_w_qkv, l1_lam_q1, l1_lam_k1, l1_lam_q2, l1_lam_k2, l1_g_subln, l1_w_out),)
    ffn_params = ((l0_g_ffn, l0_w_group, l0_b_group, l0_w_expert, l0_b_expert, l0_w_up_gate, l0_w_down),
                  (l1_g_ffn, l1_w_group, l1_b_group, l1_w_expert, l1_b_expert, l1_w_up_gate, l1_w_down))
    for layer in range(DEPTH):
        if layer % 2 == 0:
            x = x + _even_mixer(x, *even_params[layer // 2])
        else:
            x = x + _odd_mixer(x, *odd_params[layer // 2], layer_idx=layer)
        g_ffn = ffn_params[layer][0]
        x = x + _hier_moe(_rms_norm(x, g_ffn), *ffn_params[layer][1:])
    return _rms_norm(x, g_final)
```

```cpp
#include <hip/hip_runtime.h>
#include <cstdio>
#include <cstdint>
#include <cmath>

constexpr int NB = 4, SEQ = 4096, DM = 2048, NTOK = NB * SEQ;
constexpr int CONVW = 1024, MLA_H = 8, QRANK = 512, KVRANK = 256;
constexpr int EVEN_IN = 3 * CONVW + QRANK + KVRANK + 64;
constexpr int DH = 8;
constexpr int NEXP = 32, EFF = 512;
constexpr float EPS = 1e-6f;
constexpr float LAM_INIT = 0.35550906759f;


__device__ __forceinline__ int lane_fresh() { int l; asm volatile("v_mbcnt_lo_u32_b32 %0, -1, 0\n\tv_mbcnt_hi_u32_b32 %0, -1, %0" : "=v"(l)); return l; }
namespace pg8 {
#define PG8_LAS __attribute__((address_space(3)))
typedef unsigned short bf16_t;
typedef short bf16x8 __attribute__((ext_vector_type(8)));
typedef float f32x4 __attribute__((ext_vector_type(4)));
typedef unsigned u32x4 __attribute__((ext_vector_type(4)));
constexpr int BM = 256, BK = 64, HALF = 128, HTB = HALF * BK * 2  , STAGE_BYTES = 8 * HTB, NXCD = 8, WGM = 8;

__host__ __device__ __forceinline__ int lds_byte(int r, int c) { const int st = (r >> 4) * 2 + (c >> 5), rr = r & 15, cc = c & 31, ob = rr * 64 + cc * 2; return st * 1024 + (ob ^ (((ob >> 9) & 1) << 5)); }
__host__ __device__ __forceinline__ void stage_rc(int b, int& R, int& C) { const int st = b / 1024, sb = b % 1024, swz = sb ^ (((sb >> 9) & 1) << 5); R = (st >> 1) * 16 + swz / 64; C = (st & 1) * 32 + (swz % 64) / 2; }
__host__ __device__ __forceinline__ int perm32(int rho) { const int n = rho >> 4, i = rho & 15; return 8 * (i >> 2) + 4 * n + (i & 3); }

struct Unit { int pm, pn; };
struct Gemm { const bf16_t* A; const bf16_t* Bt; int M, N, K; };

struct StaticOrder {
    int nM, nN, nwg, G, c;
    __host__ __device__ void init(int M, int N, int G_, int c_) { nM = M / BM; nN = N / BM; nwg = nM * nN; G = G_; c = c_; }
    __host__ __device__ bool next(int i, Unit& u) const {
        const long L = (long)i * G + c; if (L >= nwg) return false;
        int wgid = (int)L; { const int q = nwg / NXCD, r = nwg % NXCD, xcd = wgid % NXCD, off = wgid / NXCD; wgid = (xcd < r ? xcd * (q + 1) : r * (q + 1) + (xcd - r) * q) + off; }
        const int nig = WGM * nN, gid = wgid / nig, fm = gid * WGM, gsz = (nM - fm) < WGM ? (nM - fm) : WGM;
        u.pm = fm + ((wgid % nig) % gsz); u.pn = (wgid % nig) / gsz; return true;
    }
    __device__ __forceinline__ void a_ready(const Unit&) const {}
    __device__ __forceinline__ void done(const Unit&) const {}
};

__device__ __forceinline__ unsigned cvt_pk_bf16(float lo, float hi) { unsigned r; asm volatile("v_cvt_pk_bf16_f32 %0, %1, %2" : "=v"(r) : "v"(lo), "v"(hi)); return r; }
typedef float f32x2 __attribute__((ext_vector_type(2)));

struct GroupedOrder {
    const int* tile_e; int NCT, nun, G, c;
    __device__ __forceinline__ void init(const int* te, int ntile, int nct, int G_, int c_) { tile_e = te; NCT = nct; nun = ntile * nct; G = G_; c = c_; }
    __device__ __forceinline__ bool next(int i, Unit& u) const {
        const int L = i * G + c; if (L >= nun) return false;
        const int pt = L / NCT, nt = L - pt * NCT; const int e = __builtin_amdgcn_readfirstlane(tile_e[pt]);
        u.pm = pt; u.pn = e * NCT + nt; return true;
    }
    __device__ __forceinline__ void a_ready(const Unit&) const {}
    __device__ __forceinline__ void done(const Unit&) const {}
};
struct EpiBf16S {
    static constexpr bool PERM = true, AFTER_DRAIN = false;
    bf16_t* O; int ldc; int pnmask; int ncs; size_t split_stride; float scale0;
    int hmw01 = 0, hmw2 = 0, seq = 1;
    __device__ __forceinline__ void operator()(const f32x4 (&acc)[2][2][4][2], const Unit& u, int wr, int wc, int fr, int fq) const {
        const int t = u.pn & pnmask, s = t / ncs; bf16_t* base = O + (size_t)s * split_stride; const float sc = (s == 0) ? scale0 : 1.f;
        const int row0 = u.pm * BM + wr * 64 + fr, col0 = (t - s * ncs) * BM + wc * 32 + 8 * fq;
        const int hmw = (s < 2) ? hmw01 : hmw2;
#pragma unroll
        for (int ai = 0; ai < 2; ++ai)
#pragma unroll
            for (int m = 0; m < 4; ++m) { const int row = row0 + ai * HALF + m * 16;
#pragma unroll
                for (int bj = 0; bj < 2; ++bj) { const f32x4 v0 = acc[ai][bj][m][0] * sc, v1 = acc[ai][bj][m][1] * sc; const int col = col0 + bj * HALF;
                    bf16_t* p;
                    if (hmw) { const int b = row / seq, tt = row - b * seq, hd = col / hmw, d = col - hd * hmw; p = base + ((size_t)(b * (ldc / hmw) + hd) * seq + tt) * hmw + d; }
                    else p = base + (size_t)row * ldc + col;
                    u32x4 w; w.x = cvt_pk_bf16(v0[0], v0[1]); w.y = cvt_pk_bf16(v0[2], v0[3]); w.z = cvt_pk_bf16(v1[0], v1[1]); w.w = cvt_pk_bf16(v1[2], v1[3]);
                    *(u32x4*)p = w; } }
    }
};
struct EpiQRope {
    static constexpr bool PERM = true, AFTER_DRAIN = false;
    bf16_t* O; int ldc; const float* tab; int seqmask; float scale;
    __device__ __forceinline__ void operator()(const f32x4 (&acc)[2][2][4][2], const Unit& u, int wr, int wc, int fr, int fq) const {
        const int row0 = u.pm * BM + wr * 64 + fr, col0 = u.pn * BM + wc * 32 + 8 * fq;
#pragma unroll
        for (int ai = 0; ai < 2; ++ai)
#pragma unroll
            for (int m = 0; m < 4; ++m) { const int row = row0 + ai * HALF + m * 16; const int tpos = row & seqmask, bidx = row / (seqmask + 1);
#pragma unroll
                for (int bj = 0; bj < 2; ++bj) { f32x4 v0 = acc[ai][bj][m][0], v1 = acc[ai][bj][m][1];
                    const int col = col0 + bj * HALF, d = col % 192;
                    if (d >= 128) { const float* tp = tab + ((size_t)tpos * 32 + ((d - 128) >> 1)) * 2; const f32x4 c0 = *(const f32x4*)tp, c1 = *(const f32x4*)(tp + 4);
                        f32x4 r0, r1;
                        r0[0] = v0[0] * c0[0] - v0[1] * c0[1]; r0[1] = v0[0] * c0[1] + v0[1] * c0[0]; r0[2] = v0[2] * c0[2] - v0[3] * c0[3]; r0[3] = v0[2] * c0[3] + v0[3] * c0[2];
                        r1[0] = v1[0] * c1[0] - v1[1] * c1[1]; r1[1] = v1[0] * c1[1] + v1[1] * c1[0]; r1[2] = v1[2] * c1[2] - v1[3] * c1[3]; r1[3] = v1[2] * c1[3] + v1[3] * c1[2];
                        v0 = r0; v1 = r1; }
                    v0 = v0 * scale; v1 = v1 * scale;
                    u32x4 w; w.x = cvt_pk_bf16(v0[0], v0[1]); w.y = cvt_pk_bf16(v0[2], v0[3]); w.z = cvt_pk_bf16(v1[0], v1[1]); w.w = cvt_pk_bf16(v1[2], v1[3]);
                    *(u32x4*)(O + ((size_t)(bidx * (ldc / 192) + col / 192) * (seqmask + 1) + tpos) * 192 + d) = w; } }
    }
};
struct EpiF32Res {
    static constexpr bool PERM = false, AFTER_DRAIN = false;
    const float* R; float* C; int ldc;
    __device__ __forceinline__ void operator()(const f32x4 (&acc)[2][2][4][2], const Unit& u, int wr, int wc, int fr, int fq) const {
        const int row0 = u.pm * BM + wr * 64 + fr, col0 = u.pn * BM + wc * 32 + 4 * fq;
#pragma unroll
        for (int ai = 0; ai < 2; ++ai)
#pragma unroll
            for (int m = 0; m < 4; ++m) { const size_t off = (size_t)(row0 + ai * HALF + m * 16) * ldc + col0;
#pragma unroll
                for (int bj = 0; bj < 2; ++bj)
#pragma unroll
                    for (int n = 0; n < 2; ++n) { const f32x4 r = *(const f32x4*)(R + off + bj * HALF + n * 16); *(f32x4*)(C + off + bj * HALF + n * 16) = acc[ai][bj][m][n] + r; } }
    }
};
template <bool RF32> struct EpiResBf16 {
    static constexpr bool PERM = true, AFTER_DRAIN = false;
    const void* R; bf16_t* C; int ldc;
    __device__ __forceinline__ void operator()(const f32x4 (&acc)[2][2][4][2], const Unit& u, int wr, int wc, int fr, int fq) const {
        const int row0 = u.pm * BM + wr * 64 + fr, col0 = u.pn * BM + wc * 32 + 8 * fq;
#pragma unroll
        for (int ai = 0; ai < 2; ++ai)
#pragma unroll
            for (int m = 0; m < 4; ++m) { const size_t off = (size_t)(row0 + ai * HALF + m * 16) * ldc + col0;
#pragma unroll
                for (int bj = 0; bj < 2; ++bj) { f32x4 v0 = acc[ai][bj][m][0], v1 = acc[ai][bj][m][1]; const size_t o = off + bj * HALF;
                    if constexpr (RF32) { v0 = v0 + *(const f32x4*)((const float*)R + o); v1 = v1 + *(const f32x4*)((const float*)R + o + 4); }
                    else { const u32x4 r = *(const u32x4*)((const bf16_t*)R + o);
                        v0[0] += __uint_as_float(r.x << 16); v0[1] += __uint_as_float(r.x & 0xffff0000u); v0[2] += __uint_as_float(r.y << 16); v0[3] += __uint_as_float(r.y & 0xffff0000u);
                        v1[0] += __uint_as_float(r.z << 16); v1[1] += __uint_as_float(r.z & 0xffff0000u); v1[2] += __uint_as_float(r.w << 16); v1[3] += __uint_as_float(r.w & 0xffff0000u); }
                    u32x4 w; w.x = cvt_pk_bf16(v0[0], v0[1]); w.y = cvt_pk_bf16(v0[2], v0[3]); w.z = cvt_pk_bf16(v1[0], v1[1]); w.w = cvt_pk_bf16(v1[2], v1[3]);
                    *(u32x4*)(C + o) = w; } }
    }
};
struct EpiSwiGLU {
    static constexpr bool PERM = true, AFTER_DRAIN = false;
    bf16_t* O;
    __device__ __forceinline__ void operator()(const f32x4 (&acc)[2][2][4][2], const Unit& u, int wr, int wc, int fr, int fq) const {
        const int nt = u.pn & 3; const int row0 = u.pm * BM + wr * 64 + fr, col0 = nt * 128 + wc * 32 + 8 * fq;
#pragma unroll
        for (int ai = 0; ai < 2; ++ai)
#pragma unroll
            for (int m = 0; m < 4; ++m) { bf16_t* rowp = O + (size_t)(row0 + ai * HALF + m * 16) * 512 + col0; float h[8];
#pragma unroll
                for (int n = 0; n < 2; ++n)
#pragma unroll
                    for (int i = 0; i < 4; ++i) { const float g = acc[ai][0][m][n][i], up = acc[ai][1][m][n][i];
                        h[4 * n + i] = g * __builtin_amdgcn_rcpf(1.f + __builtin_amdgcn_exp2f(-1.4426950408889634f * g)) * up; }
                u32x4 w; w.x = cvt_pk_bf16(h[0], h[1]); w.y = cvt_pk_bf16(h[2], h[3]); w.z = cvt_pk_bf16(h[4], h[5]); w.w = cvt_pk_bf16(h[6], h[7]);
                *(u32x4*)rowp = w; }
    }
};

template <class Epi, class Sched, bool ALIGN_EPI = false, bool SP2 = false>
__device__ __forceinline__ void gemm_phase(PG8_LAS unsigned char* lds, const Gemm g, const Sched& S, const Epi& E, const int wid) {
    const int lane = lane_fresh(), tid = wid * 64 + lane, wr = wid >> 2, wc = wid & 3, fr = lane & 15, fq = lane >> 4;
    const int K = g.K, nt = K / BK;
    unsigned voffA[2], voffB[2];
#pragma unroll
    for (int i = 0; i < 2; ++i) { int R, C; stage_rc(tid * 16 + i * 8192, R, C); const int Rb = Epi::PERM ? ((R & ~31) + perm32(R & 31)) : R;
        voffA[i] = (unsigned)(R * K + C) * 2u; voffB[i] = (unsigned)(Rb * K + C) * 2u; }
    const size_t kstep = (size_t)(BK * 2);
    const size_t hstep = (size_t)HALF * K * 2;
    const size_t tstep = 2 * hstep;
    const unsigned ldsw = (unsigned)wid * 1024u;
    const int aoff = lds_byte(wr * 64 + fr, fq * 8), boff = lds_byte(wc * 32 + fr, fq * 8);
#define PG8_SA(b, h) (((b) * 2 + (h)) * HTB)
#define PG8_SB(b, h) ((4 + (b) * 2 + (h)) * HTB)
#define PG8_STAGE(bufoff, gbase, voff) do { _Pragma("unroll") for (int _i = 0; _i < 2; ++_i) \
        __builtin_amdgcn_global_load_lds((const unsigned*)((const char*)(gbase) + (voff)[_i]), (PG8_LAS unsigned*)(lds + (bufoff) + ldsw + _i * 8192), 16, 0, 0); } while (0)
#define PG8_LDA(dst, b, h) do { _Pragma("unroll") for (int m = 0; m < 4; ++m) _Pragma("unroll") for (int k = 0; k < 2; ++k) dst[m][k] = *(const PG8_LAS bf16x8*)(lds + PG8_SA(b, h) + aoff + m * 2048 + k * 1024); } while (0)
#define PG8_LDB(dst, b, h) do { _Pragma("unroll") for (int n = 0; n < 2; ++n) _Pragma("unroll") for (int k = 0; k < 2; ++k) dst[n][k] = *(const PG8_LAS bf16x8*)(lds + PG8_SB(b, h) + boff + n * 2048 + k * 1024); } while (0)
#define PG8_MMA(ai, bj, At, Bt) do { __builtin_amdgcn_s_setprio(1); _Pragma("unroll") for (int m = 0; m < 4; ++m) _Pragma("unroll") for (int n = 0; n < 2; ++n) _Pragma("unroll") for (int k = 0; k < 2; ++k) \
        acc[ai][bj][m][n] = __builtin_amdgcn_mfma_f32_16x16x32_bf16(Bt[n][k], At[m][k], acc[ai][bj][m][n], 0, 0, 0); __builtin_amdgcn_s_setprio(0); } while (0)
#define PG8_WAIT_V(n) asm volatile("s_waitcnt vmcnt(" #n ")" ::: "memory")
#define PG8_WAIT_L(n) asm volatile("s_waitcnt lgkmcnt(" #n ")" ::: "memory")
#define PG8_BAR __builtin_amdgcn_s_barrier()
#define PG8_SCHED __builtin_amdgcn_sched_barrier(0)
    Unit cur, nxt; int ui = 0;
    if (!S.next(0, cur)) return;
    f32x4 acc[2][2][4][2];
#pragma unroll
    for (int a = 0; a < 2; ++a)
#pragma unroll
        for (int b = 0; b < 2; ++b)
#pragma unroll
            for (int m = 0; m < 4; ++m)
#pragma unroll
                for (int n = 0; n < 2; ++n) acc[a][b][m][n] = (f32x4){0.f, 0.f, 0.f, 0.f};
    bf16x8 At[4][2], B0[2][2], B1[2][2];
    const char* cA = (const char*)g.A + (size_t)cur.pm * tstep; const char* cB = (const char*)g.Bt + (size_t)cur.pn * tstep;
    S.a_ready(cur);
    if constexpr (SP2) {
        PG8_STAGE(PG8_SB(0, 0), cB, voffB); PG8_STAGE(PG8_SB(0, 1), cB + hstep, voffB); PG8_STAGE(PG8_SA(0, 0), cA, voffA); PG8_STAGE(PG8_SA(0, 1), cA + hstep, voffA);
        if (wr == 1) PG8_BAR;
        PG8_WAIT_V(2); PG8_BAR;
        PG8_STAGE(PG8_SB(1, 0), cB + kstep, voffB); PG8_STAGE(PG8_SA(1, 0), cA + kstep, voffA); PG8_STAGE(PG8_SB(1, 1), cB + hstep + kstep, voffB);
        PG8_WAIT_V(6); PG8_BAR;
    } else {
        PG8_STAGE(PG8_SB(0, 0), cB, voffB); PG8_STAGE(PG8_SA(0, 0), cA, voffA); PG8_STAGE(PG8_SB(0, 1), cB + hstep, voffB); PG8_STAGE(PG8_SA(0, 1), cA + hstep, voffA);
        if (wr == 1) PG8_BAR;
        PG8_WAIT_V(4); PG8_BAR;
        PG8_STAGE(PG8_SB(1, 0), cB + kstep, voffB); PG8_STAGE(PG8_SA(1, 0), cA + kstep, voffA); PG8_STAGE(PG8_SB(1, 1), cB + hstep + kstep, voffB);
        PG8_WAIT_V(6); PG8_BAR;
    }
    for (;;) {
        const bool has_next = S.next(ui + 1, nxt);
        const char* nA = has_next ? (const char*)g.A + (size_t)nxt.pm * tstep : cA; const char* nB = has_next ? (const char*)g.Bt + (size_t)nxt.pn * tstep : cB;
        for (int t = 0; t < nt; t += 2) {
            const bool last = (t == nt - 2);
            const char* a1 = cA + (size_t)(t + 1) * kstep;
            const char* a2 = last ? nA : cA + (size_t)(t + 2) * kstep; const char* b2 = last ? nB : cB + (size_t)(t + 2) * kstep;
            const char* a3 = a2 + kstep; const char* b3 = b2 + kstep;
            if (last && has_next) S.a_ready(nxt);
            if constexpr (SP2) {
            PG8_LDB(B0, 0, 0); PG8_LDB(B1, 0, 1); PG8_SCHED; PG8_LDA(At, 0, 0); PG8_STAGE(PG8_SA(1, 1), a1 + hstep, voffA);
            PG8_WAIT_V(8); PG8_WAIT_L(0); PG8_BAR; PG8_MMA(0, 0, At, B0); PG8_MMA(0, 1, At, B1); PG8_BAR; PG8_SCHED;
            PG8_LDA(At, 0, 1); PG8_STAGE(PG8_SB(0, 0), b2, voffB); PG8_STAGE(PG8_SB(0, 1), b2 + hstep, voffB); PG8_STAGE(PG8_SA(0, 0), a2, voffA);
            PG8_WAIT_V(8); PG8_WAIT_L(0); PG8_BAR; PG8_MMA(1, 0, At, B0); PG8_MMA(1, 1, At, B1); PG8_BAR; PG8_SCHED;
            PG8_LDB(B0, 1, 0); PG8_LDB(B1, 1, 1); PG8_SCHED; PG8_LDA(At, 1, 0); PG8_STAGE(PG8_SA(0, 1), a2 + hstep, voffA);
            PG8_WAIT_V(8); PG8_WAIT_L(0); PG8_BAR; PG8_MMA(0, 0, At, B0); PG8_MMA(0, 1, At, B1); PG8_BAR; PG8_SCHED;
            PG8_LDA(At, 1, 1); PG8_STAGE(PG8_SB(1, 0), b3, voffB); PG8_STAGE(PG8_SB(1, 1), b3 + hstep, voffB); PG8_STAGE(PG8_SA(1, 0), a3, voffA);
            PG8_WAIT_V(8); PG8_WAIT_L(0); PG8_BAR; PG8_MMA(1, 0, At, B0); PG8_MMA(1, 1, At, B1); PG8_BAR; PG8_SCHED;
            } else {
            PG8_LDB(B0, 0, 0); PG8_SCHED; PG8_LDA(At, 0, 0); PG8_STAGE(PG8_SA(1, 1), a1 + hstep, voffA);
            PG8_WAIT_L(8); PG8_BAR; PG8_WAIT_L(0); PG8_MMA(0, 0, At, B0); PG8_BAR; PG8_SCHED;
            PG8_LDB(B1, 0, 1); PG8_STAGE(PG8_SB(0, 0), b2, voffB);
            PG8_BAR; PG8_WAIT_L(0); PG8_MMA(0, 1, At, B1); PG8_BAR;
            PG8_LDA(At, 0, 1); PG8_STAGE(PG8_SA(0, 0), a2, voffA);
            PG8_BAR; PG8_WAIT_L(0); PG8_MMA(1, 0, At, B0); PG8_BAR; PG8_SCHED;
            PG8_STAGE(PG8_SB(0, 1), b2 + hstep, voffB);
            PG8_WAIT_V(6); PG8_BAR; PG8_MMA(1, 1, At, B1); PG8_BAR;
            PG8_LDB(B0, 1, 0); PG8_SCHED; PG8_LDA(At, 1, 0); PG8_STAGE(PG8_SA(0, 1), a2 + hstep, voffA);
            PG8_WAIT_L(8); PG8_BAR; PG8_WAIT_L(0); PG8_MMA(0, 0, At, B0); PG8_BAR; PG8_SCHED;
            PG8_LDB(B1, 1, 1); PG8_STAGE(PG8_SB(1, 0), b3, voffB);
            PG8_BAR; PG8_WAIT_L(0); PG8_MMA(0, 1, At, B1); PG8_BAR;
            PG8_LDA(At, 1, 1); PG8_STAGE(PG8_SA(1, 0), a3, voffA);
            PG8_BAR; PG8_WAIT_L(0); PG8_MMA(1, 0, At, B0); PG8_BAR; PG8_SCHED;
            PG8_STAGE(PG8_SB(1, 1), b3 + hstep, voffB);
            PG8_WAIT_V(6); PG8_BAR; PG8_MMA(1, 1, At, B1); PG8_BAR;
            }
        }
        if constexpr (ALIGN_EPI) { if (wr == 0) PG8_BAR; }
        if constexpr (!Epi::AFTER_DRAIN) { E(acc, cur, wr, wc, fr, fq); S.done(cur); }
        if (!has_next) break;
#pragma unroll
        for (int a = 0; a < 2; ++a)
#pragma unroll
            for (int b = 0; b < 2; ++b)
#pragma unroll
                for (int m = 0; m < 4; ++m)
#pragma unroll
                    for (int n = 0; n < 2; ++n) acc[a][b][m][n] = (f32x4){0.f, 0.f, 0.f, 0.f};
        cur = nxt; cA = nA; cB = nB; ++ui;
        if constexpr (ALIGN_EPI) { if (wr == 1) PG8_BAR; }
    }
    PG8_WAIT_V(0);
    if constexpr (!ALIGN_EPI) { if (wr == 0) PG8_BAR; }
    PG8_BAR;
    if constexpr (Epi::AFTER_DRAIN) { E.fused(acc, cur, wr, wc, fr, fq, lds, wid, lane); S.done(cur); }
#undef PG8_SA
#undef PG8_SB
#undef PG8_STAGE
#undef PG8_LDA
#undef PG8_LDB
#undef PG8_MMA
#undef PG8_WAIT_V
#undef PG8_WAIT_L
#undef PG8_BAR
#undef PG8_SCHED
}
}

namespace att {
typedef unsigned short bf16;
typedef short bf16x8 __attribute__((ext_vector_type(8)));
typedef short s16x4 __attribute__((ext_vector_type(4)));
typedef float f32x16 __attribute__((ext_vector_type(16)));
typedef float f32x4 __attribute__((ext_vector_type(4)));
typedef unsigned u32x4 __attribute__((ext_vector_type(4)));
constexpr int NW = 8, QBLK = 32, KVBLK = 64, QB = NW * QBLK;
constexpr int SHM_V = KVBLK * 128 * 2, SHM_K = KVBLK * 128 * 2, SHM_K2 = KVBLK * 64 * 2;
constexpr int OFF_K = 0, OFF_V = 3 * SHM_K, OFF_K2 = OFF_V + 3 * SHM_V, OFF_QR = OFF_K2 + 3 * SHM_K2, LDS_BYTES = OFF_QR + NW * 4096;
constexpr float THR2 = 11.5416f;
#define KSWZ(row, colB) ((row) * 256 + ((colB) ^ (((row) & 15) << 4)))
#define K2SWZ(row, colB) ((row) * 128 + ((colB) ^ ((((row) >> 1) & 7) << 4)))
#define SBAR() __builtin_amdgcn_sched_barrier(0)
__device__ __forceinline__ int v_st(int k, int c) { const int kk = (k & ~0xC) | ((k & 4) << 1) | ((k & 8) >> 1); return ((kk >> 3) * 4 + (c >> 5)) * 512 + ((kk & 7) * 32 + (c & 31)) * 2; }
__device__ __forceinline__ int v_rd_base(int lane) { return ((lane & 3) << 3) | (((lane >> 2) & 3) << 6) | (((lane >> 4) & 1) << 5) | (((lane >> 5) & 1) << 8); }
constexpr int v_rd_off(int d0, int ks, int half) { return d0 * 512 + ks * 4096 + half * 2048; }
__device__ __forceinline__ int crow(int r, int hi) { return (r & 3) + 8 * (r >> 2) + 4 * hi; }
__device__ __forceinline__ unsigned cvtpk(float lo, float hi) { unsigned r; asm volatile("v_cvt_pk_bf16_f32 %0, %1, %2" : "=v"(r) : "v"(lo), "v"(hi)); return r; }
__device__ __forceinline__ bf16x8 load8(const bf16* p) { return *reinterpret_cast<const bf16x8*>(p); }
__device__ __forceinline__ void mask_tile(f32x16& p0, f32x16& p1, int dq) {
    const float NEG = -__builtin_inff();
#pragma unroll
    for (int r = 0; r < 16; ++r) { const int c = (r & 3) + 8 * (r >> 2); if (dq - c < 0) p0[r] = NEG; if (dq - c - 32 < 0) p1[r] = NEG; }
}
__device__ __forceinline__ bool softmax_tile(f32x16& p0, f32x16& p1, float& m_reg, float& l_reg, float& alpha, bf16x8& pa0, bf16x8& pa1, bf16x8& pa2, bf16x8& pa3) {
    float pmax = p0[0];
#pragma unroll
    for (int r = 1; r < 16; ++r) pmax = fmaxf(pmax, p0[r]);
#pragma unroll
    for (int r = 0; r < 16; ++r) pmax = fmaxf(pmax, p1[r]);
    { auto rr = __builtin_amdgcn_permlane32_swap(__float_as_uint(pmax), __float_as_uint(pmax), false, false);
      pmax = fmaxf(__uint_as_float(rr[0]), __uint_as_float(rr[1])); }
    bool resc = false; float mn = m_reg; alpha = 1.f;
    if (__builtin_expect(!__all((pmax - m_reg) <= THR2), 0)) { mn = fmaxf(m_reg, pmax); alpha = __builtin_amdgcn_exp2f(m_reg - mn); m_reg = mn; resc = true; }
#pragma unroll
    for (int r = 0; r < 16; ++r) { p0[r] = __builtin_amdgcn_exp2f(p0[r] - mn); p1[r] = __builtin_amdgcn_exp2f(p1[r] - mn); }
    float ps = 0;
#pragma unroll
    for (int r = 0; r < 16; ++r) ps += p0[r];
#pragma unroll
    for (int r = 0; r < 16; ++r) ps += p1[r];
    { auto rr = __builtin_amdgcn_permlane32_swap(__float_as_uint(ps), __float_as_uint(ps), false, false);
      ps = __uint_as_float(rr[0]) + __uint_as_float(rr[1]); }
    l_reg = l_reg * alpha + ps;
#define PK8(P, B_, OUT) do { u32x4 w = {cvtpk(P[B_+0], P[B_+1]), cvtpk(P[B_+2], P[B_+3]), cvtpk(P[B_+4], P[B_+5]), cvtpk(P[B_+6], P[B_+7])}; OUT = *reinterpret_cast<bf16x8*>(&w); } while (0)
    PK8(p0, 0, pa0); PK8(p0, 8, pa1); PK8(p1, 0, pa2); PK8(p1, 8, pa3);
#undef PK8
    return resc;
}
template <bool ROPE, bool ALIBI>
__device__ __forceinline__ void qkt(f32x16& p0, f32x16& p1, const char* kimg, const char* k2img, int r32, int hi, const bf16x8* qr, const char* qr2, const bf16x8& qb, const bf16x8& kb0, const bf16x8& kb1) {
#pragma unroll
    for (int d0 = 0; d0 < 8; ++d0) { const char* a = kimg + KSWZ(r32, (d0 * 16 + hi * 8) * 2);
        bf16x8 b0 = *reinterpret_cast<const bf16x8*>(a);
        bf16x8 b1 = *reinterpret_cast<const bf16x8*>(a + 32 * 256);
        if (d0 == 0) { p0 = __builtin_amdgcn_mfma_f32_32x32x16_bf16(b0, qr[0], f32x16{}, 0, 0, 0); p1 = __builtin_amdgcn_mfma_f32_32x32x16_bf16(b1, qr[0], f32x16{}, 0, 0, 0); }
        else { p0 = __builtin_amdgcn_mfma_f32_32x32x16_bf16(b0, qr[d0], p0, 0, 0, 0); p1 = __builtin_amdgcn_mfma_f32_32x32x16_bf16(b1, qr[d0], p1, 0, 0, 0); } }
    if constexpr (ROPE) {
#pragma unroll
        for (int d0 = 0; d0 < 4; ++d0) { const char* a = k2img + K2SWZ(r32, (d0 * 16 + hi * 8) * 2);
            bf16x8 b0 = *reinterpret_cast<const bf16x8*>(a);
            bf16x8 b1 = *reinterpret_cast<const bf16x8*>(a + 32 * 128);
            const bf16x8 q2 = *reinterpret_cast<const bf16x8*>(qr2 + d0 * 1024);
            p0 = __builtin_amdgcn_mfma_f32_32x32x16_bf16(b0, q2, p0, 0, 0, 0);
            p1 = __builtin_amdgcn_mfma_f32_32x32x16_bf16(b1, q2, p1, 0, 0, 0); }
    }
    if constexpr (ALIBI) { p0 = __builtin_amdgcn_mfma_f32_32x32x16_bf16(kb0, qb, p0, 0, 0, 0); p1 = __builtin_amdgcn_mfma_f32_32x32x16_bf16(kb1, qb, p1, 0, 0, 0); }
}
typedef short v4i16_t __attribute__((ext_vector_type(4)));
typedef __attribute__((address_space(3))) v4i16_t* lds_v4i16_ptr;
__device__ __forceinline__ s16x4 vtr(int addr) { return __builtin_bit_cast(s16x4, __builtin_amdgcn_ds_read_tr16_b64_v4i16((lds_v4i16_ptr)(uintptr_t)(unsigned)addr)); }
__device__ __forceinline__ void pv_tile(f32x16* o, int vb0, bf16x8 pa0, bf16x8 pa1, bf16x8 pa2, bf16x8 pa3) {
#pragma unroll
    for (int d0 = 0; d0 < 4; ++d0) { const int b_ = vb0 + d0 * 512;
        const s16x4 l0 = vtr(b_), h0 = vtr(b_ + 2048), l1 = vtr(b_ + 4096), h1 = vtr(b_ + 6144), l2 = vtr(b_ + 8192), h2 = vtr(b_ + 10240), l3 = vtr(b_ + 12288), h3 = vtr(b_ + 14336);
        o[d0] = __builtin_amdgcn_mfma_f32_32x32x16_bf16((bf16x8){l0[0], l0[1], l0[2], l0[3], h0[0], h0[1], h0[2], h0[3]}, pa0, o[d0], 0, 0, 0);
        o[d0] = __builtin_amdgcn_mfma_f32_32x32x16_bf16((bf16x8){l1[0], l1[1], l1[2], l1[3], h1[0], h1[1], h1[2], h1[3]}, pa1, o[d0], 0, 0, 0);
        o[d0] = __builtin_amdgcn_mfma_f32_32x32x16_bf16((bf16x8){l2[0], l2[1], l2[2], l2[3], h2[0], h2[1], h2[2], h2[3]}, pa2, o[d0], 0, 0, 0);
        o[d0] = __builtin_amdgcn_mfma_f32_32x32x16_bf16((bf16x8){l3[0], l3[1], l3[2], l3[3], h3[0], h3[1], h3[2], h3[3]}, pa3, o[d0], 0, 0, 0); }
}
struct BlockRef { const bf16* Q; const bf16* K; const bf16* K2; const bf16* V; bf16* O; int P0; float sl2; };
__device__ __forceinline__ void glds16(const void* sbase, unsigned voff, unsigned lds_dst) { unsigned keep;
    asm volatile("s_mov_b32 %0, m0\n\ts_mov_b32 m0, %3\n\ts_nop 0\n\tglobal_load_lds_dwordx4 %2, %1\n\ts_mov_b32 m0, %0" : "=&s"(keep) : "s"(sbase), "v"(voff), "s"(lds_dst) : "memory"); }
template <int QP, int KP, int VP, int OP, bool ROPE, bool ALIBI>
__device__ __forceinline__ void attn_block(const BlockRef& cur, char* lds, const int wid) {
    const int lane = lane_fresh(), r32 = lane & 31, hi = lane >> 5;
    const int NT = cur.P0 / KVBLK + QB / KVBLK;
    const bool lead = wid < 4;
    const int qlo = cur.P0 + wid * QBLK, qm = qlo + r32 - 4 * hi;
    float l_reg = 0; f32x16 o[4] = {};
    const unsigned ldsb = (unsigned)(uintptr_t)lds;
    const int vb0 = (int)ldsb + OFF_V + v_rd_base(lane);
    const float sl2 = cur.sl2;
    unsigned koff[2], voff[2], k2off = 0;
#pragma unroll
    for (int i = 0; i < 2; ++i) { const int p = wid * 2 + i;
        { const int row = 4 * p + (lane >> 4), c = (lane & 15) ^ (row & 15); koff[i] = (unsigned)(row * KP + c * 8) * 2u; }
        { const int sidx = 2 * p + (lane >> 5), kk = (sidx >> 2) * 8 + ((lane & 31) >> 2), k = kk  , c = (sidx & 3) * 32 + (lane & 3) * 8;
          voff[i] = (unsigned)(k * VP + c) * 2u; } }
    if constexpr (ROPE) { const int row = 8 * wid + (lane >> 3), c = (lane & 7) ^ ((row >> 1) & 7); k2off = (unsigned)(row * 64 + c * 8) * 2u; }
#define TILE(s_) (NT - 1 - (s_))
#define ISSUE_K(s_, slot) do { const int t_ = TILE(s_); const char* kb_ = (const char*)cur.K + (size_t)t_ * (KVBLK * KP * 2);                                                            \
        glds16(kb_, koff[0], ldsb + OFF_K + (slot) * SHM_K + (wid * 2 + 0) * 1024); glds16(kb_, koff[1], ldsb + OFF_K + (slot) * SHM_K + (wid * 2 + 1) * 1024);                        \
        if constexpr (ROPE) glds16((const char*)cur.K2 + (size_t)t_ * (KVBLK * 64 * 2), k2off, ldsb + OFF_K2 + (slot) * SHM_K2 + wid * 1024); } while (0)
#define ISSUE_V(s_, slot) do { const char* vb_ = (const char*)cur.V + (size_t)TILE(s_) * (KVBLK * VP * 2);                                                                             \
        glds16(vb_, voff[0], ldsb + OFF_V + (slot) * SHM_V + (wid * 2 + 0) * 1024); glds16(vb_, voff[1], ldsb + OFF_V + (slot) * SHM_V + (wid * 2 + 1) * 1024); } while (0)
#define BAR_ALL() asm volatile("s_waitcnt lgkmcnt(0)\n\ts_barrier" ::: "memory")
    f32x16 p0, p1; float alpha = 1.f, m_reg = -1e30f; bool resc = false; bf16x8 pa0, pa1, pa2, pa3; bf16x8 qr[8];
    char* qr2 = lds + OFF_QR + wid * 4096 + lane * 16;
    bf16x8 qb = {}, kb0 = {}, kb1 = {};
    if constexpr (ALIBI) { const unsigned shi = cvtpk(sl2, 0.f) & 0xffffu, slo = cvtpk(sl2 - __uint_as_float(shi << 16), 0.f) & 0xffffu;
        const unsigned s64hi = cvtpk(64.f * __uint_as_float(shi << 16), 0.f) & 0xffffu, s64lo = cvtpk(64.f * __uint_as_float(slo << 16), 0.f) & 0xffffu;
        const unsigned nq = cvtpk(-(float)(wid * QBLK + r32), 0.f) & 0xffffu, k0 = cvtpk((float)r32, 0.f) & 0xffffu, k1 = cvtpk((float)(32 + r32), 0.f) & 0xffffu;
        u32x4 q_ = {nq | (nq << 16), shi | (slo << 16), s64hi | (s64lo << 16), 0u}, a_ = {shi | (slo << 16), k0 | (k0 << 16), 0u, 0u}, b_ = {shi | (slo << 16), k1 | (k1 << 16), 0u, 0u};
        if (hi) { q_ = (u32x4){0u, 0u, 0u, 0u}; }
        qb = *reinterpret_cast<bf16x8*>(&q_); kb0 = *reinterpret_cast<bf16x8*>(&a_); kb1 = *reinterpret_cast<bf16x8*>(&b_); }
#pragma unroll
    for (int d0 = 0; d0 < 8; ++d0) qr[d0] = load8(cur.Q + (size_t)(wid * QBLK + r32) * QP + d0 * 16 + hi * 8);
    if constexpr (ROPE) {
#pragma unroll
        for (int d0 = 0; d0 < 4; ++d0) *(bf16x8*)(qr2 + d0 * 1024) = load8(cur.Q + (size_t)(wid * QBLK + r32) * QP + 128 + d0 * 16 + hi * 8); }
    ISSUE_K(0, 0); ISSUE_V(0, 0); ISSUE_K(1, 1);
    asm volatile("s_waitcnt vmcnt(0) lgkmcnt(0)\n\ts_barrier" ::: "memory");
#pragma unroll
    for (int d0 = 0; d0 < 8; ++d0) asm volatile("" : "+v"(qr[d0]));
    int ks = 0, vs = 0;
    int kis = 2, vis = 1;
    int rq = 0;
#define REQUEST() do { const int sk_ = rq + 2, sv_ = rq + 1; if (sv_ < NT) { if (sk_ < NT) ISSUE_K(sk_, kis); ISSUE_V(sv_, vis); } kis = (kis == 2) ? 0 : kis + 1; vis = (vis == 2) ? 0 : vis + 1; ++rq; } while (0)
#define LANDED() do { if (rq + 1 < NT) { if constexpr (ROPE) asm volatile("s_waitcnt vmcnt(5)" ::: "memory"); else asm volatile("s_waitcnt vmcnt(4)" ::: "memory"); } else asm volatile("s_waitcnt vmcnt(0)" ::: "memory"); } while (0)
#define SET_N(s_) do { if constexpr (ALIBI) { const unsigned nn = cvtpk((float)(TILE(s_) - cur.P0 / KVBLK), 0.f) & 0xffffu; u32x4 a_ = *reinterpret_cast<u32x4*>(&kb0), b_ = *reinterpret_cast<u32x4*>(&kb1); a_[2] = nn | (nn << 16); b_[2] = a_[2]; \
        kb0 = *reinterpret_cast<bf16x8*>(&a_); kb1 = *reinterpret_cast<bf16x8*>(&b_); } } while (0)
#define QKT(s_) do { SET_N(s_); qkt<ROPE, ALIBI>(p0, p1, lds + OFF_K + ks * SHM_K, lds + OFF_K2 + ks * SHM_K2, r32, hi, qr, qr2, qb, kb0, kb1); ks = (ks == 2) ? 0 : ks + 1; } while (0)
#define PV() do { pv_tile(o, vb0 + vs * SHM_V, pa0, pa1, pa2, pa3); vs = (vs == 2) ? 0 : vs + 1; } while (0)
#define RESCALE() do { if (resc) { _Pragma("unroll") for (int d_ = 0; d_ < 4; ++d_) _Pragma("unroll") for (int r = 0; r < 16; ++r) o[d_][r] *= alpha; } } while (0)
#define SOFTMAX(s_, MASKED) do { if (MASKED) { const int kb_ = TILE(s_) * KVBLK; if (kb_ + KVBLK - 1 > qlo) mask_tile(p0, p1, qm - kb_); } resc = softmax_tile(p0, p1, m_reg, l_reg, alpha, pa0, pa1, pa2, pa3); } while (0)
    if (!lead) REQUEST();
    if (lead) { QKT(0); }
    BAR_ALL();
    if (lead) { REQUEST(); SOFTMAX(0, true); } else { QKT(0); }
    LANDED(); BAR_ALL();
    if (!lead) { REQUEST(); SOFTMAX(0, true); BAR_ALL(); }
    for (int s_ = 1; s_ < NT; ++s_) {
        RESCALE();
        QKT(s_); PV();
        if constexpr (ROPE) { __builtin_amdgcn_sched_group_barrier(0x100, 8, 0);
            _Pragma("unroll") for (int g_ = 0; g_ < 20; ++g_) { __builtin_amdgcn_sched_group_barrier(0x8, 1, 0); __builtin_amdgcn_sched_group_barrier(0x100, 1, 0); }
            _Pragma("unroll") for (int g_ = 0; g_ < 16; ++g_) { __builtin_amdgcn_sched_group_barrier(0x8, 1, 0); __builtin_amdgcn_sched_group_barrier(0x100, 2, 0); }
            __builtin_amdgcn_sched_group_barrier(0x8, 4, 0); }
        else { __builtin_amdgcn_sched_group_barrier(0x100, 16, 0);
            __builtin_amdgcn_sched_group_barrier(0x8, 2, 0);
            _Pragma("unroll") for (int g_ = 0; g_ < 16; ++g_) { __builtin_amdgcn_sched_group_barrier(0x100, 2, 0); __builtin_amdgcn_sched_group_barrier(0x8, 1, 0); }
            __builtin_amdgcn_sched_group_barrier(0x8, 16, 0); }
        if (!lead) LANDED();
        BAR_ALL();
        REQUEST();
        if (s_ < 4) SOFTMAX(s_, true); else SOFTMAX(s_, false);
        if (lead) LANDED();
        BAR_ALL();
    }
    RESCALE();
    PV();
    BAR_ALL();
    if (lead) BAR_ALL();
#undef REQUEST
#undef LANDED
#undef SET_N
#undef QKT
#undef PV
#undef RESCALE
#undef SOFTMAX
    { const float rl = __builtin_amdgcn_rcpf(l_reg);
      int lane_e = lane; asm volatile("" : "+v"(lane_e));
      bf16* Ow = cur.O + (size_t)(wid * QBLK + (lane_e & 31)) * OP + 4 * (lane_e >> 5);
#pragma unroll
      for (int d0 = 0; d0 < 4; ++d0)
#pragma unroll
          for (int g = 0; g < 4; ++g) { uint2 w; w.x = cvtpk(o[d0][4 * g] * rl, o[d0][4 * g + 1] * rl); w.y = cvtpk(o[d0][4 * g + 2] * rl, o[d0][4 * g + 3] * rl);
              *(uint2*)(Ow + d0 * 32 + 8 * g) = w; } }
    asm volatile("s_waitcnt vmcnt(0) lgkmcnt(0)\n\ts_barrier" ::: "memory");
#undef TILE
#undef ISSUE_K
#undef ISSUE_V
#undef BAR_ALL
}
}

#define GAS __attribute__((address_space(1)))
#define LAS __attribute__((address_space(3)))
typedef unsigned short bf16;
typedef unsigned v4u __attribute__((ext_vector_type(4)));
typedef float f32x4 __attribute__((ext_vector_type(4)));
typedef short bf16x8 __attribute__((ext_vector_type(8)));
typedef GAS unsigned gu32;
typedef GAS unsigned long long gu64;
#define RLX_AGENT __ATOMIC_RELAXED, __HIP_MEMORY_SCOPE_AGENT
#define LDS_WAIT() asm volatile("s_waitcnt lgkmcnt(0)" ::: "memory")
#define VM_WAIT() asm volatile("s_waitcnt vmcnt(0)" ::: "memory")
__device__ __forceinline__ unsigned long long rt() { return __builtin_amdgcn_s_memrealtime(); }
__device__ __forceinline__ unsigned f2bf(float f) { unsigned u = __builtin_bit_cast(unsigned, f); return (u + 0x7fffu + ((u >> 16) & 1u)) >> 16; }
__device__ __forceinline__ unsigned pk2(float lo, float hi) { return f2bf(lo) | (f2bf(hi) << 16); }

#define XB_TMO      128
#define XB_XCNT(j)  (256  + 64 * (j))
#define XB_XSUB(j)  (1280 + 64 * (j))
#define XB_XGEN(j)  (2304 + 64 * (j))
#define XB_TOP      3328
#define XB_TOPGEN   3392
#define XCD_BAR_WORDS 3456
#define XB_SPIN_CAP (1u << 18)

__device__ __forceinline__ unsigned xb_ld(unsigned* p)              { return __hip_atomic_load(p, __ATOMIC_RELAXED, __HIP_MEMORY_SCOPE_AGENT); }
__device__ __forceinline__ unsigned xb_add(unsigned* p, unsigned v) { return __hip_atomic_fetch_add(p, v, __ATOMIC_RELAXED, __HIP_MEMORY_SCOPE_AGENT); }
__device__ __forceinline__ unsigned xb_xcc_id() { return (unsigned)__builtin_amdgcn_s_getreg((3 << 11) | 20) & 0xFu; }
#define XB_SPIN(cond, bar) do { unsigned _sp = 0; while (cond) { __builtin_amdgcn_s_sleep(1); \
    if ((++_sp & 255u) == 0u) { if (xb_ld(&(bar)[XB_TMO])) break; if (_sp > XB_SPIN_CAP) { atomicAdd(&(bar)[XB_TMO], 1u); break; } } } } while (0)

struct XcdBarrier {
    unsigned* bar; unsigned x;
    volatile LAS unsigned* st;
};

__device__ __forceinline__ XcdBarrier xcd_barrier_post(unsigned* bar, volatile LAS unsigned* st) {
    XcdBarrier b; b.bar = bar; b.x = xb_xcc_id(); b.st = st;
    if (threadIdx.x == 0) (void)xb_add(&bar[XB_XCNT(b.x)], 1u);
    return b;
}
__device__ __forceinline__ void xcd_barrier_complete(unsigned* bar, unsigned x, unsigned& nloc, unsigned& nx) {
    const unsigned G = gridDim.x * gridDim.y * gridDim.z;
    unsigned sum, cnt, mine, sp = 0u;
    for (;;) {
        sum = 0u; cnt = 0u; mine = 0u;
#pragma unroll
        for (unsigned j = 0; j < 16; ++j) { const unsigned c = xb_ld(&bar[XB_XCNT(j)]); sum += c; cnt += (c > 0u) ? 1u : 0u; mine = (j == x) ? c : mine; }
        if (sum == G) break;
        __builtin_amdgcn_s_sleep(1);
        if ((++sp & 255u) == 0u) { if (xb_ld(&bar[XB_TMO])) break; if (sp > XB_SPIN_CAP) { atomicAdd(&bar[XB_TMO], 1u); break; } }
    }
    nloc = mine > 0u ? mine : 1u; nx = cnt > 0u ? cnt : 1u;
}

__device__ __forceinline__ void xcd_barrier(const XcdBarrier& b, const bool leader  ) {
    asm volatile("s_waitcnt vmcnt(0)" ::: "memory");
    __syncthreads();
    if (leader) {
        unsigned* bar = b.bar;
        __builtin_amdgcn_s_waitcnt(0);
        unsigned nloc = b.st[0], nx = b.st[1];
        if (nloc == 0u) { xcd_barrier_complete(bar, b.x, nloc, nx); b.st[0] = nloc; b.st[1] = nx; }
        const unsigned old = xb_add(&bar[XB_XSUB(b.x)], 1u);
        const unsigned gen = old / nloc;
        if (old + 1u == (gen + 1u) * nloc) {
            __builtin_amdgcn_fence(__ATOMIC_RELEASE, "agent");
            asm volatile("s_waitcnt vmcnt(0)" ::: "memory");
            const unsigned og = xb_add(&bar[XB_TOP], 1u);
            const unsigned tg = og / nx;
            if (og + 1u == (tg + 1u) * nx) xb_add(&bar[XB_TOPGEN], 1u);
            else XB_SPIN(xb_ld(&bar[XB_TOPGEN]) == tg, bar);
            __builtin_amdgcn_fence(__ATOMIC_ACQUIRE, "agent");
            xb_add(&bar[XB_XGEN(b.x)], 1u);
            asm volatile("s_waitcnt vmcnt(0)" ::: "memory");
        } else {
            XB_SPIN(xb_ld(&bar[XB_XGEN(b.x)]) == gen, bar);
            __builtin_amdgcn_fence(__ATOMIC_ACQUIRE, "agent");
            asm volatile("s_waitcnt vmcnt(0)" ::: "memory");
        }
    }
    __syncthreads();
}

constexpr int NWAVES = 8;
constexpr size_t MiB = 1u << 20;
constexpr size_t WS_CTL = 0, CTL_ZERO_BYTES = 1 * MiB;
constexpr size_t WS_ROPE = 1 * MiB;
constexpr size_t WS_WIN = 2 * MiB, WS_WUQ = 18 * MiB, WS_WUKV = 20 * MiB, WS_WR0 = 21 * MiB, WS_WR1 = 21 * MiB + 512 * 1024, WS_WO0 = 22 * MiB, WS_WQKV = 30 * MiB, WS_WO1 = 54 * MiB;
constexpr size_t WS_WUP0 = 64 * MiB, WS_WDN0 = 192 * MiB, WS_WUP1 = 256 * MiB, WS_WDN1 = 384 * MiB;
constexpr size_t WS_XR = 448 * MiB, WS_HN = 576 * MiB;
constexpr size_t WS_ZIN = 640 * MiB, WS_Q = 640 * MiB, WS_KNV = 688 * MiB, WS_CAT = 832 * MiB, WS_QL = 896 * MiB, WS_KVL = 912 * MiB, WS_KR = 920 * MiB;
constexpr size_t WS_Q1 = 640 * MiB, WS_K1 = 704 * MiB, WS_V1 = 768 * MiB, WS_ATT = 832 * MiB, WS_OD = 896 * MiB;
constexpr size_t WS_AP = 640 * MiB, WS_HS = 800 * MiB, WS_Y = 840 * MiB, WS_MOE = 1000 * MiB, WS_END = 1024 * MiB;
constexpr int NCHUNK = NTOK / 64;
constexpr int MAXTILE = 160;
constexpr int MO_EID = 0, MO_EW = 2 * NTOK  , MO_LRANK = 4 * NTOK, MO_TOKSLOT = 6 * NTOK, MO_HIST = 8 * NTOK  , MO_TILEE = MO_HIST + NCHUNK * 32  , MO_NTILE = MO_TILEE + 256, MO_RSTD = MO_NTILE + 64  ;
constexpr int CW_BAR = 4096;
constexpr int RING_OFF = 0, RING_BYTES = 155648;
constexpr int LDSCTL_OFF = RING_BYTES, MISC_OFF = LDSCTL_OFF + 320;
constexpr int LDS_BYTES = 156672;
static_assert(MISC_OFF + 128 <= LDS_BYTES && att::LDS_BYTES <= RING_BYTES && pg8::STAGE_BYTES <= RING_BYTES, "LDS map");

struct Frame {
    LAS unsigned char* lds; volatile LAS unsigned* MISC; gu32* ctl; unsigned char* ws;
    int wave, vcu, G;
};
__device__ __forceinline__ float wave_sum(float v) {
#pragma unroll
    for (int o = 1; o < 64; o <<= 1) v += __shfl_xor(v, o);
    return v;
}
__device__ __forceinline__ unsigned cvtpk(float lo, float hi) { unsigned r; asm volatile("v_cvt_pk_bf16_f32 %0, %1, %2" : "=v"(r) : "v"(lo), "v"(hi)); return r; }
__device__ __forceinline__ float bf_lo(unsigned w) { return __uint_as_float(w << 16); }
__device__ __forceinline__ float bf_hi(unsigned w) { return __uint_as_float(w & 0xffff0000u); }
typedef unsigned v2u __attribute__((ext_vector_type(2)));

template <class RowMap>
__device__ __forceinline__ void tr_item(const float* W, int K, int N, bf16* WT, LAS float* scr, int item, int lane, RowMap rm) {
    const int nblk = N / 64, kb = item / nblk, nb = item - kb * nblk, k0 = 64 * kb, n0 = 64 * nb;
    const float* src = W + (size_t)(k0 + (lane >> 4)) * N + n0 + (lane & 15) * 4;
    f32x4 v[16];
#pragma unroll
    for (int i = 0; i < 16; ++i) v[i] = *(const f32x4*)(src + (size_t)(4 * i) * N);
#pragma unroll
    for (int i = 0; i < 16; ++i) { LAS float* d = scr + (4 * i + (lane >> 4)) * 65 + (lane & 15) * 4; d[0] = v[i][0]; d[1] = v[i][1]; d[2] = v[i][2]; d[3] = v[i][3]; }
    LDS_WAIT(); asm volatile("" ::: "memory");
    const int c = lane & 7;
#pragma unroll
    for (int j = 0; j < 8; ++j) { const int n = (lane >> 3) + 8 * j; const LAS float* s = scr + (8 * c) * 65 + n;
        v4u o; o.x = cvtpk(s[0 * 65], s[1 * 65]); o.y = cvtpk(s[2 * 65], s[3 * 65]); o.z = cvtpk(s[4 * 65], s[5 * 65]); o.w = cvtpk(s[6 * 65], s[7 * 65]);
        *(GAS v4u*)(WT + (size_t)rm(n0 + n) * K + k0 + 8 * c) = o; }
    LDS_WAIT(); asm volatile("" ::: "memory");
}
struct TrDesc { const float* src; bf16* dst; int N, K, k0, n0, type; };
__device__ __forceinline__ int tr_dst_row(int type, int n) {
    if (type == 1) { const int h = n / 192, d = n - h * 192; if (d < 128) return n; const int i = d - 128; return h * 192 + 128 + ((i < 32) ? 2 * i : 2 * (i - 32) + 1); }
    if (type == 2) { const int h = n >> 8, c = n & 255; return (c < 128) ? h * 128 + c : 1024 + h * 128 + (c - 128); }
    if (type == 3) { const int bj = n >> 9, r = n & 511; return (r >> 7) * 256 + bj * 128 + (r & 127); }
    return n;
}
__device__ __forceinline__ void tr_load(const TrDesc& d, f32x4 (&v)[16], int lane) {
    const float* src = d.src + (size_t)(lane >> 4) * d.N + (lane & 15) * 4;
#pragma unroll
    for (int i = 0; i < 16; ++i) v[i] = *(const GAS f32x4*)(src + (size_t)(4 * i) * d.N);
}
__device__ __forceinline__ void tr_store(const TrDesc& d, const f32x4 (&v)[16], LAS float* scr, int lane) {
#pragma unroll
    for (int i = 0; i < 16; ++i) { LAS float* p = scr + (4 * i + (lane >> 4)) * 65 + (lane & 15) * 4; p[0] = v[i][0]; p[1] = v[i][1]; p[2] = v[i][2]; p[3] = v[i][3]; }
    LDS_WAIT(); asm volatile("" ::: "memory");
    const int c = lane & 7;
#pragma unroll
    for (int j = 0; j < 8; ++j) { const int n = (lane >> 3) + 8 * j; const LAS float* q = scr + (8 * c) * 65 + n;
        v4u o; o.x = cvtpk(q[0 * 65], q[1 * 65]); o.y = cvtpk(q[2 * 65], q[3 * 65]); o.z = cvtpk(q[4 * 65], q[5 * 65]); o.w = cvtpk(q[6 * 65], q[7 * 65]);
        *(GAS v4u*)(d.dst + (size_t)tr_dst_row(d.type, d.n0 + n) * d.K + d.k0 + 8 * c) = o; }
    LDS_WAIT(); asm volatile("" ::: "memory");
}
struct RmId { __device__ __forceinline__ int operator()(int n) const { return n; } };
struct RmUq { __device__ __forceinline__ int operator()(int n) const { const int h = n / 192, d = n - h * 192; if (d < 128) return n; const int i = d - 128; return h * 192 + 128 + ((i < 32) ? 2 * i : 2 * (i - 32) + 1); } };
struct RmUkv { __device__ __forceinline__ int operator()(int n) const { const int h = n >> 8, c = n & 255; return (c < 128) ? h * 128 + c : 1024 + h * 128 + (c - 128); } };
struct RmUp { __device__ __forceinline__ int operator()(int n) const { const int bj = n >> 9, r = n & 511; return (r >> 7) * 256 + bj * 128 + (r & 127); } };
__device__ __forceinline__ void norm_row_to_bf16(const float* xrow, const float* g, bf16* orow, int lane) {
    const GAS f32x4* xr = (const GAS f32x4*)xrow + lane; const GAS f32x4* gr = (const GAS f32x4*)g + lane;
    f32x4 v[8]; float s = 0.f;
#pragma unroll
    for (int j = 0; j < 8; ++j) { v[j] = xr[64 * j]; s += (v[j].x * v[j].x + v[j].y * v[j].y) + (v[j].z * v[j].z + v[j].w * v[j].w); }
    const float rstd = rsqrtf(wave_sum(s) * (1.f / DM) + EPS);
    GAS v2u* o8 = (GAS v2u*)orow + lane;
#pragma unroll
    for (int j = 0; j < 8; ++j) { const f32x4 gg = gr[64 * j]; v2u w; w.x = cvtpk(v[j].x * rstd * gg.x, v[j].y * rstd * gg.y); w.y = cvtpk(v[j].z * rstd * gg.z, v[j].w * rstd * gg.w); o8[64 * j] = w; }
}
struct In { const float* p[32]; };
__device__ __forceinline__ void p0_prologue(Frame& F, const In& in) {
    const int f_lane = lane_fresh(), f_tid = F.wave * 64 + f_lane;
    LAS float* scr = (LAS float*)(F.lds + RING_OFF) + F.wave * (64 * 65);
    const int gw = F.vcu * NWAVES + F.wave, NGW = F.G * NWAVES;
    unsigned char* ws = F.ws;
    constexpr int I_IN = (DM / 64) * (EVEN_IN / 64), I_UQ = (QRANK / 64) * (1536 / 64), I_UKV = (KVRANK / 64) * (2048 / 64), I_O = (DM / 64) * (DM / 64), I_QKV = (DM / 64) * (6144 / 64);
    constexpr int I_UP = (DM / 64) * (1024 / 64), I_DN = (EFF / 64) * (DM / 64);
    constexpr int N_DENSE = I_IN + I_UQ + I_UKV + 2 * I_O + I_QKV, N_MOE = NEXP * (I_UP + I_DN), NITEMS = N_DENSE + 2 * N_MOE;
    auto decode = [&](int it) -> TrDesc {
        TrDesc d; int r = it; const float* W; bf16* WT; int K, N, type = 0;
        if (r < I_IN) { W = in.p[2]; K = DM; N = EVEN_IN; WT = (bf16*)(ws + WS_WIN); }
        else if ((r -= I_IN) < I_UQ) { W = in.p[5]; K = QRANK; N = 1536; WT = (bf16*)(ws + WS_WUQ); type = 1; }
        else if ((r -= I_UQ) < I_UKV) { W = in.p[7]; K = KVRANK; N = 2048; WT = (bf16*)(ws + WS_WUKV); type = 2; }
        else if ((r -= I_UKV) < I_O) { W = in.p[8]; K = DM; N = DM; WT = (bf16*)(ws + WS_WO0); }
        else if ((r -= I_O) < I_QKV) { W = in.p[17]; K = DM; N = 6144; WT = (bf16*)(ws + WS_WQKV); }
        else if ((r -= I_QKV) < I_O) { W = in.p[23]; K = DM; N = DM; WT = (bf16*)(ws + WS_WO1); }
        else { r -= I_O; const int layer = r / N_MOE; r -= layer * N_MOE;
            if (r < NEXP * I_UP) { const int e = r / I_UP; r -= e * I_UP; W = in.p[layer ? 29 : 14] + (size_t)e * DM * 1024; K = DM; N = 1024; WT = (bf16*)(ws + (layer ? WS_WUP1 : WS_WUP0)) + (size_t)e * 1024 * DM; type = 3; }
            else { r -= NEXP * I_UP; const int e = r / I_DN; r -= e * I_DN; W = in.p[layer ? 30 : 15] + (size_t)e * EFF * DM; K = EFF; N = DM; WT = (bf16*)(ws + (layer ? WS_WDN1 : WS_WDN0)) + (size_t)e * DM * EFF; } }
        const int nblk = N / 64, kb = r / nblk, nb = r - kb * nblk;
        d.k0 = 64 * kb; d.n0 = 64 * nb; d.src = W + (size_t)d.k0 * N + d.n0; d.dst = WT; d.N = N; d.K = K; d.type = type; return d; };
    { f32x4 va[16], vb[16]; int it = gw;
      if (it < NITEMS) { TrDesc da = decode(it); tr_load(da, va, f_lane);
          for (;;) {
              const int it1 = it + NGW; TrDesc db = da; if (it1 < NITEMS) { db = decode(it1); tr_load(db, vb, f_lane); }
              tr_store(da, va, scr, f_lane);
              if (it1 >= NITEMS) break;
              const int it2 = it1 + NGW; if (it2 < NITEMS) { da = decode(it2); tr_load(da, va, f_lane); }
              tr_store(db, vb, scr, f_lane);
              if (it2 >= NITEMS) break;
              it = it2; } } }
    { GAS v4u* z = (GAS v4u*)(ws + WS_WIN + (size_t)EVEN_IN * DM * 2); const int nz = (4096 - EVEN_IN) * DM * 2 / 16;
      for (int i = blockIdx.x * 512 + f_tid; i < nz; i += F.G * 512) z[i] = (v4u){0u, 0u, 0u, 0u}; }
    { float* tab = (float*)(ws + WS_ROPE);
      for (int i = blockIdx.x * 512 + f_tid; i < SEQ * 32; i += F.G * 512) { const int t = i >> 5, k = i & 31; const float inv = powf(10000.0f, -(float)(2 * k) / 64.0f), ang = (float)t * inv; tab[2 * i] = cosf(ang); tab[2 * i + 1] = sinf(ang); } }
    for (int layer = 0; layer < 2; ++layer) {
        const float* g = in.p[layer ? 24 : 9]; const float* wg = in.p[layer ? 25 : 10]; const float* we = in.p[layer ? 27 : 12];
        GAS v4u* dst = (GAS v4u*)(ws + (layer ? WS_WR1 : WS_WR0));
        for (int i = blockIdx.x * 512 + f_tid; i < 64 * 3 * 64; i += F.G * 512) {
            const int ln = i & 63, nt = (i >> 6) % 3, ks = (i >> 6) / 3, o = 16 * nt + (ln & 15), kb = 32 * ks + 8 * (ln >> 4);
            float hi[8], lo[8];
#pragma unroll
            for (int j = 0; j < 8; ++j) { const int k = kb + j; float w = 0.f; if (o < 4) w = wg[k * 4 + o]; else if (o < 36) w = we[k * 32 + (o - 4)]; w *= g[k];
                const float h = __uint_as_float(cvtpk(w, 0.f) << 16); hi[j] = h; lo[j] = w - h; }
            v4u a, b; a.x = cvtpk(hi[0], hi[1]); a.y = cvtpk(hi[2], hi[3]); a.z = cvtpk(hi[4], hi[5]); a.w = cvtpk(hi[6], hi[7]);
            b.x = cvtpk(lo[0], lo[1]); b.y = cvtpk(lo[2], lo[3]); b.z = cvtpk(lo[4], lo[5]); b.w = cvtpk(lo[6], lo[7]);
            dst[(size_t)((ks * 3 + nt) * 2 + 0) * 64 + ln] = a; dst[(size_t)((ks * 3 + nt) * 2 + 1) * 64 + ln] = b; }
    }
    for (int m = gw; m < NTOK; m += NGW) norm_row_to_bf16(in.p[0] + (size_t)m * DM, in.p[1], (bf16*)(ws + WS_HN) + (size_t)m * DM, f_lane);
}

__device__ __forceinline__ void p2_even_local(Frame& F, const In& in) {
    const int f_lane = lane_fresh(), f_tid = F.wave * 64 + f_lane;
    const int gw = F.vcu * NWAVES + F.wave, NGW = F.G * NWAVES, lane = f_lane;
    const bf16* zin = (const bf16*)(F.ws + WS_ZIN); bf16* cat = (bf16*)(F.ws + WS_CAT); bf16* ql = (bf16*)(F.ws + WS_QL); bf16* kvl = (bf16*)(F.ws + WS_KVL); bf16* kr = (bf16*)(F.ws + WS_KR);
    const float* conv_w = in.p[3]; const float* g_q = in.p[4]; const float* g_kv = in.p[6]; const float* tab = (const float*)(F.ws + WS_ROPE);
    for (int n = gw; n < NTOK; n += NGW) {
        const int tpos = n & (SEQ - 1); const bf16* z = zin + (size_t)n * 4096;
#pragma unroll
        for (int i = 0; i < 2; ++i) { const int c = 8 * lane + 512 * i; float acc[8] = {0.f, 0.f, 0.f, 0.f, 0.f, 0.f, 0.f, 0.f};
#pragma unroll
            for (int j = 0; j < 3; ++j) { if (tpos - 2 + j >= 0) { const bf16* zz = z - (size_t)(2 - j) * 4096;
                    const v4u gc = *(const GAS v4u*)(zz + CONVW + c), uu = *(const GAS v4u*)(zz + 2 * CONVW + c);
                    const f32x4 w0 = *(const GAS f32x4*)(conv_w + j * CONVW + c), w1 = *(const GAS f32x4*)(conv_w + j * CONVW + c + 4);
                    acc[0] += w0.x * bf_lo(gc.x) * bf_lo(uu.x); acc[1] += w0.y * bf_hi(gc.x) * bf_hi(uu.x); acc[2] += w0.z * bf_lo(gc.y) * bf_lo(uu.y); acc[3] += w0.w * bf_hi(gc.y) * bf_hi(uu.y);
                    acc[4] += w1.x * bf_lo(gc.z) * bf_lo(uu.z); acc[5] += w1.y * bf_hi(gc.z) * bf_hi(uu.z); acc[6] += w1.z * bf_lo(gc.w) * bf_lo(uu.w); acc[7] += w1.w * bf_hi(gc.w) * bf_hi(uu.w); } }
            const v4u gb = *(const GAS v4u*)(z + c); v4u o;
            o.x = cvtpk(bf_lo(gb.x) * acc[0], bf_hi(gb.x) * acc[1]); o.y = cvtpk(bf_lo(gb.y) * acc[2], bf_hi(gb.y) * acc[3]); o.z = cvtpk(bf_lo(gb.z) * acc[4], bf_hi(gb.z) * acc[5]); o.w = cvtpk(bf_lo(gb.w) * acc[6], bf_hi(gb.w) * acc[7]);
            *(GAS v4u*)(cat + (size_t)n * DM + c) = o; }
        { const v4u q = *(const GAS v4u*)(z + 3 * CONVW + 8 * lane); float v[8] = {bf_lo(q.x), bf_hi(q.x), bf_lo(q.y), bf_hi(q.y), bf_lo(q.z), bf_hi(q.z), bf_lo(q.w), bf_hi(q.w)}; float s = 0.f;
#pragma unroll
          for (int j = 0; j < 8; ++j) s += v[j] * v[j];
          const float r = rsqrtf(wave_sum(s) * (1.f / QRANK) + EPS); const f32x4 g0 = *(const GAS f32x4*)(g_q + 8 * lane), g1 = *(const GAS f32x4*)(g_q + 8 * lane + 4);
          v4u o; o.x = cvtpk(v[0] * r * g0.x, v[1] * r * g0.y); o.y = cvtpk(v[2] * r * g0.z, v[3] * r * g0.w); o.z = cvtpk(v[4] * r * g1.x, v[5] * r * g1.y); o.w = cvtpk(v[6] * r * g1.z, v[7] * r * g1.w);
          *(GAS v4u*)(ql + (size_t)n * QRANK + 8 * lane) = o; }
        { const v2u q = *(const GAS v2u*)(z + 3 * CONVW + QRANK + 4 * lane); float v[4] = {bf_lo(q.x), bf_hi(q.x), bf_lo(q.y), bf_hi(q.y)};
          const float s = (v[0] * v[0] + v[1] * v[1]) + (v[2] * v[2] + v[3] * v[3]);
          const float r = rsqrtf(wave_sum(s) * (1.f / KVRANK) + EPS); const f32x4 g0 = *(const GAS f32x4*)(g_kv + 4 * lane);
          v2u o; o.x = cvtpk(v[0] * r * g0.x, v[1] * r * g0.y); o.y = cvtpk(v[2] * r * g0.z, v[3] * r * g0.w);
          *(GAS v2u*)(kvl + (size_t)n * KVRANK + 4 * lane) = o; }
        if (lane < 32) { const float t1 = __uint_as_float((unsigned)z[3 * CONVW + QRANK + KVRANK + lane] << 16), t2 = __uint_as_float((unsigned)z[3 * CONVW + QRANK + KVRANK + 32 + lane] << 16);
          const float c = tab[((size_t)tpos * 32 + lane) * 2], s = tab[((size_t)tpos * 32 + lane) * 2 + 1];
          *(GAS unsigned*)(kr + (size_t)n * 64 + 2 * lane) = cvtpk(t1 * c - t2 * s, t1 * s + t2 * c); }
    }
}

__device__ __forceinline__ void p6_route(Frame& F, const float* g, const float* bg, const float* be, const unsigned char* wfrag) {
    const int f_lane = lane_fresh(), f_tid = F.wave * 64 + f_lane;
    LAS float* LG = (LAS float*)(F.lds + RING_OFF);
    LAS float* SS = LG + 2 * 64 * 48;
    LAS float* RS = SS + 128;
    LAS int* HI = (LAS int*)(RS + 64);
    const int lane = f_lane, w = F.wave, tq = w & 3, kh = w >> 2;
    const bf16* XR = (const bf16*)(F.ws + WS_XR); bf16* HN = (bf16*)(F.ws + WS_HN);
    int* mo = (int*)(F.ws + WS_MOE);
    for (int chunk = F.vcu; chunk < NCHUNK; chunk += F.G) {
        const int n0 = chunk * 64;
        if (f_tid < 32) HI[f_tid] = 0;
        { pg8::f32x4 acc[3] = {{0.f, 0.f, 0.f, 0.f}, {0.f, 0.f, 0.f, 0.f}, {0.f, 0.f, 0.f, 0.f}}; float ss = 0.f;
          const bf16* xp = XR + (size_t)(n0 + 16 * tq + (lane & 15)) * DM + kh * 1024 + 8 * (lane >> 4);
          const GAS v4u* wf = (const GAS v4u*)wfrag + (size_t)(kh * 32) * 6 * 64 + lane;
#pragma unroll 4
          for (int ks = 0; ks < 32; ++ks) {
              const v4u h = *(const GAS v4u*)(xp + 32 * ks);
              { const float a0 = bf_lo(h.x), a1 = bf_hi(h.x), a2 = bf_lo(h.y), a3 = bf_hi(h.y), a4 = bf_lo(h.z), a5 = bf_hi(h.z), a6 = bf_lo(h.w), a7 = bf_hi(h.w);
                ss += (a0 * a0 + a1 * a1) + (a2 * a2 + a3 * a3) + (a4 * a4 + a5 * a5) + (a6 * a6 + a7 * a7); }
              const bf16x8 ah = __builtin_bit_cast(bf16x8, h);
#pragma unroll
              for (int nt = 0; nt < 3; ++nt) { const bf16x8 bh = __builtin_bit_cast(bf16x8, wf[(size_t)((ks * 3 + nt) * 2 + 0) * 64]), bl = __builtin_bit_cast(bf16x8, wf[(size_t)((ks * 3 + nt) * 2 + 1) * 64]);
                  acc[nt] = __builtin_amdgcn_mfma_f32_16x16x32_bf16(ah, bh, acc[nt], 0, 0, 0); acc[nt] = __builtin_amdgcn_mfma_f32_16x16x32_bf16(ah, bl, acc[nt], 0, 0, 0); } }
          ss += __shfl_xor(ss, 16); ss += __shfl_xor(ss, 32);
          if (lane < 16) SS[kh * 64 + 16 * tq + lane] = ss;
#pragma unroll
          for (int nt = 0; nt < 3; ++nt)
#pragma unroll
              for (int r = 0; r < 4; ++r) LG[(kh * 64 + 16 * tq + 4 * (lane >> 4) + r) * 48 + 16 * nt + (lane & 15)] = acc[nt][r]; }
        __syncthreads();
        if (f_tid < 64) {
            const int t = f_tid, n = n0 + t; const float rstd = rsqrtf((SS[t] + SS[64 + t]) * (1.f / DM) + EPS); ((float*)mo)[MO_RSTD + n] = rstd;
            float gl[4];
#pragma unroll
            for (int i = 0; i < 4; ++i) gl[i] = (LG[t * 48 + i] + LG[(64 + t) * 48 + i]) * rstd + bg[i];
            int gi = 0; float gm = gl[0];
#pragma unroll
            for (int i = 1; i < 4; ++i) if (gl[i] > gm) { gm = gl[i]; gi = i; }
            float den = 0.f;
#pragma unroll
            for (int i = 0; i < 4; ++i) den += expf(gl[i] - gm);
            const float gp = 1.f / den;
            float el[8];
#pragma unroll
            for (int i = 0; i < 8; ++i) el[i] = (LG[t * 48 + 4 + gi * 8 + i] + LG[(64 + t) * 48 + 4 + gi * 8 + i]) * rstd + be[gi * 8 + i];
            int i1 = 0; float m1 = el[0];
#pragma unroll
            for (int i = 1; i < 8; ++i) if (el[i] > m1) { m1 = el[i]; i1 = i; }
            int i2 = -1; float m2 = -INFINITY;
#pragma unroll
            for (int i = 0; i < 8; ++i) if (i != i1 && (i2 < 0 || el[i] > m2)) { m2 = el[i]; i2 = i; }
            const float w1 = 1.f / (1.f + expf(m2 - m1)), w2 = 1.f - w1; const int e1 = gi * 8 + i1, e2 = gi * 8 + i2;
            mo[MO_EID + 2 * n] = e1; mo[MO_EID + 2 * n + 1] = e2; ((float*)mo)[MO_EW + 2 * n] = gp * w1; ((float*)mo)[MO_EW + 2 * n + 1] = gp * w2;
            mo[MO_LRANK + 2 * n] = atomicAdd((int*)&HI[e1], 1); mo[MO_LRANK + 2 * n + 1] = atomicAdd((int*)&HI[e2], 1);
        }
        __syncthreads();
        if (f_tid < 32) mo[MO_HIST + chunk * 32 + f_tid] = HI[f_tid];
        __syncthreads();
    }
}

__device__ __forceinline__ void p7_dispatch(Frame& F, const float* g) {
    const int f_lane = lane_fresh(), f_tid = F.wave * 64 + f_lane;
    LAS int* PS = (LAS int*)(F.lds + RING_OFF);
    LAS int* OFF = PS + 1024;
    LAS int* BASE = OFF + 64;
    int* mo = (int*)(F.ws + WS_MOE); const int* hist = mo + MO_HIST;
    const bf16* XR = (const bf16*)(F.ws + WS_XR); bf16* AP = (bf16*)(F.ws + WS_AP);
    for (int chunk = F.vcu; chunk < NCHUNK; chunk += F.G) {
        { const int e = f_tid & 31, part = f_tid >> 5; int sa = 0, sb = 0;
          for (int c = part * (NCHUNK / 16); c < (part + 1) * (NCHUNK / 16); ++c) { const int h = hist[c * 32 + e]; sa += h; if (c < chunk) sb += h; }
          PS[part * 32 + e] = sa; PS[512 + part * 32 + e] = sb; }
        __syncthreads();
        if (f_tid < 32) { int tot = 0, bef = 0;
#pragma unroll
            for (int p = 0; p < 16; ++p) { tot += PS[p * 32 + f_tid]; bef += PS[512 + p * 32 + f_tid]; }
            PS[f_tid] = (tot + 255) & ~255; BASE[f_tid] = bef; }
        __syncthreads();
        if (f_tid == 0) { int o = 0; for (int e = 0; e < NEXP; ++e) { OFF[e] = o; o += PS[e]; } OFF[NEXP] = o; }
        __syncthreads();
        if (chunk == 0) {
            for (int t = f_tid; t < MAXTILE; t += 512) { const int s = t * 256; int e = 0;
#pragma unroll
                for (int i = 1; i < NEXP; ++i) if (s >= OFF[i]) e = i;
                mo[MO_TILEE + t] = e; }
            if (f_tid == 0) mo[MO_NTILE] = OFF[NEXP] >> 8;
        }
        const int n0 = chunk * 64;
        for (int t = F.wave; t < 64; t += NWAVES) {
            const int n = n0 + t, i = 2 * n; const int e0 = mo[MO_EID + i], e1 = mo[MO_EID + i + 1];
            const int s0 = OFF[e0] + BASE[e0] + mo[MO_LRANK + i], s1 = OFF[e1] + BASE[e1] + mo[MO_LRANK + i + 1]; const float rstd = ((const float*)mo)[MO_RSTD + n];
            if (f_lane == 0) { mo[MO_TOKSLOT + i] = s0; mo[MO_TOKSLOT + i + 1] = s1; }
            const GAS v4u* src = (const GAS v4u*)(XR + (size_t)n * DM) + f_lane; GAS v4u* d0 = (GAS v4u*)(AP + (size_t)s0 * DM) + f_lane; GAS v4u* d1 = (GAS v4u*)(AP + (size_t)s1 * DM) + f_lane;
#pragma unroll
            for (int q = 0; q < 4; ++q) { const v4u x = src[64 * q]; const GAS f32x4* gp = (const GAS f32x4*)g + 2 * (f_lane + 64 * q); const f32x4 g0 = gp[0], g1 = gp[1]; v4u o;
                o.x = cvtpk(bf_lo(x.x) * rstd * g0.x, bf_hi(x.x) * rstd * g0.y); o.y = cvtpk(bf_lo(x.y) * rstd * g0.z, bf_hi(x.y) * rstd * g0.w);
                o.z = cvtpk(bf_lo(x.z) * rstd * g1.x, bf_hi(x.z) * rstd * g1.y); o.w = cvtpk(bf_lo(x.w) * rstd * g1.z, bf_hi(x.w) * rstd * g1.w);
                d0[64 * q] = o; d1[64 * q] = o; }
        }
        __syncthreads();
    }
}

template <bool FINAL>
__device__ __forceinline__ void p10_combine(Frame& F, const float* g, float* out) {
    const int f_lane = lane_fresh(), f_tid = F.wave * 64 + f_lane;
    const int gw = F.vcu * NWAVES + F.wave, NGW = F.G * NWAVES, lane = f_lane;
    bf16* XR = (bf16*)(F.ws + WS_XR); const bf16* Y = (const bf16*)(F.ws + WS_Y); bf16* HN = (bf16*)(F.ws + WS_HN); const int* mo = (const int*)(F.ws + WS_MOE);
    for (int n = gw; n < NTOK; n += NGW) {
        const int s0 = mo[MO_TOKSLOT + 2 * n], s1 = mo[MO_TOKSLOT + 2 * n + 1]; const float w0 = ((const float*)mo)[MO_EW + 2 * n], w1 = ((const float*)mo)[MO_EW + 2 * n + 1];
        GAS v2u* xr = (GAS v2u*)(XR + (size_t)n * DM) + lane; const GAS v2u* y0 = (const GAS v2u*)(Y + (size_t)s0 * DM) + lane; const GAS v2u* y1 = (const GAS v2u*)(Y + (size_t)s1 * DM) + lane;
        f32x4 v[8]; float s = 0.f;
#pragma unroll
        for (int j = 0; j < 8; ++j) { const v2u xb = xr[64 * j]; const f32x4 x = {bf_lo(xb.x), bf_hi(xb.x), bf_lo(xb.y), bf_hi(xb.y)}; const v2u a = y0[64 * j], b = y1[64 * j];
            v[j].x = x.x + w0 * bf_lo(a.x) + w1 * bf_lo(b.x); v[j].y = x.y + w0 * bf_hi(a.x) + w1 * bf_hi(b.x); v[j].z = x.z + w0 * bf_lo(a.y) + w1 * bf_lo(b.y); v[j].w = x.w + w0 * bf_hi(a.y) + w1 * bf_hi(b.y);
            s += (v[j].x * v[j].x + v[j].y * v[j].y) + (v[j].z * v[j].z + v[j].w * v[j].w); }
        const float rstd = rsqrtf(wave_sum(s) * (1.f / DM) + EPS); const GAS f32x4* gr = (const GAS f32x4*)g + lane;
        if constexpr (FINAL) { GAS f32x4* o = (GAS f32x4*)(out + (size_t)n * DM) + lane;
#pragma unroll
            for (int j = 0; j < 8; ++j) { const f32x4 gg = gr[64 * j]; o[64 * j] = (f32x4){v[j].x * rstd * gg.x, v[j].y * rstd * gg.y, v[j].z * rstd * gg.z, v[j].w * rstd * gg.w}; } }
        else { GAS v2u* o8 = (GAS v2u*)(HN + (size_t)n * DM) + lane;
#pragma unroll
            for (int j = 0; j < 8; ++j) { const f32x4 gg = gr[64 * j]; { v2u xo; xo.x = cvtpk(v[j].x, v[j].y); xo.y = cvtpk(v[j].z, v[j].w); xr[64 * j] = xo; } v2u o; o.x = cvtpk(v[j].x * rstd * gg.x, v[j].y * rstd * gg.y); o.y = cvtpk(v[j].z * rstd * gg.z, v[j].w * rstd * gg.w); o8[64 * j] = o; } }
    }
}

__device__ __forceinline__ void p13_diff_combine(Frame& F, const In& in) {
    const int f_lane = lane_fresh(), f_tid = F.wave * 64 + f_lane;
    const int gw = F.vcu * NWAVES + F.wave, NGW = F.G * NWAVES, lane = f_lane;
    const bf16* OD = (const bf16*)(F.ws + WS_OD); bf16* ATT = (bf16*)(F.ws + WS_ATT);
    float a = in.p[18][lane] * in.p[19][lane] + in.p[18][64 + lane] * in.p[19][64 + lane], c = in.p[20][lane] * in.p[21][lane] + in.p[20][64 + lane] * in.p[21][64 + lane];
    const float lam = expf(wave_sum(a)) - expf(wave_sum(c)) + LAM_INIT;
    const f32x4 gg = *((const GAS f32x4*)in.p[22] + lane);
    for (int i = gw; i < NTOK * DH; i += NGW) {
        const int n = i >> 3, h = i & 7;
        const int b_ = n / SEQ, t_ = n - b_ * SEQ; const size_t ob = ((size_t)((b_ * 8 + h) * 2) * SEQ + t_) * 256;
        const v2u o0 = *((const GAS v2u*)(OD + ob) + lane), o1 = *((const GAS v2u*)(OD + ob + (size_t)SEQ * 256) + lane);
        const float v0 = bf_lo(o0.x) - lam * bf_lo(o1.x), v1 = bf_hi(o0.x) - lam * bf_hi(o1.x), v2 = bf_lo(o0.y) - lam * bf_lo(o1.y), v3 = bf_hi(o0.y) - lam * bf_hi(o1.y);
        const float r = rsqrtf(wave_sum((v0 * v0 + v1 * v1) + (v2 * v2 + v3 * v3)) * (1.f / 256.f) + EPS) * (1.f - LAM_INIT);
        v2u o; o.x = cvtpk(v0 * r * gg.x, v1 * r * gg.y); o.y = cvtpk(v2 * r * gg.z, v3 * r * gg.w);
        *((GAS v2u*)(ATT + (size_t)n * DM + h * 256) + lane) = o;
    }
}

constexpr float LOG2E = 1.4426950408889634f;
#ifndef MLA_NDV
#define MLA_NDV 4
#endif
struct MlaRef { __device__ __forceinline__ att::BlockRef operator()(unsigned char* ws, int L, int pass) const {
    const int x = L & 7, bh = L >> 3, b = bh >> 3, h = bh & 7, qb = pass ? 15 - x : x; const size_t r0 = (size_t)b * SEQ;
    att::BlockRef r; r.Q = (const bf16*)(ws + WS_Q) + ((size_t)bh * SEQ + qb * 256) * 192; r.K = (const bf16*)(ws + WS_KNV) + (size_t)(b * 16 + h) * SEQ * 128; r.K2 = (const bf16*)(ws + WS_KR) + r0 * 64;
    r.V = (const bf16*)(ws + WS_KNV) + (size_t)(b * 16 + 8 + h) * SEQ * 128; r.O = (bf16*)(ws + WS_CAT) + (r0 + qb * 256) * 2048 + 1024 + h * 128; r.P0 = qb * 256; r.sl2 = 0.f; return r;
} };
struct DiffRef { __device__ __forceinline__ att::BlockRef operator()(unsigned char* ws, int L, int pass) const {
    const int x = L & 7, vq = (L >> 3) & 3, bh = L >> 5, j = vq >> 1, vh = vq & 1, b = bh >> 3, h = bh & 7, qb = pass ? 15 - x : x;
    att::BlockRef r; r.Q = (const bf16*)(ws + WS_Q1) + ((size_t)(bh * 2 + j) * SEQ + qb * 256) * 128; r.K = (const bf16*)(ws + WS_K1) + (size_t)(bh * 2 + j) * SEQ * 128; r.K2 = nullptr;
    r.V = (const bf16*)(ws + WS_V1) + (size_t)bh * SEQ * 256 + vh * 128; r.O = (bf16*)(ws + WS_OD) + ((size_t)(bh * 2 + j) * SEQ + qb * 256) * 256 + vh * 128; r.P0 = qb * 256;
    r.sl2 = exp2f(-(float)(h + 1)) * LOG2E; (void)b; return r;
} };
template <int QP, int KP, int VP, int OP, bool ROPE, bool ALIBI, class RefFn, class ItemFn>
__device__ __forceinline__ void attn_phase(char* lds, unsigned char* ws, RefFn ref, ItemFn items, const int wid) {
    for (int i = 0;; ++i) { const int L = items(i); if (L < 0) break;
        for (int pass = 0; pass < 2; ++pass) { const att::BlockRef cur = ref(ws, L, pass); att::attn_block<QP, KP, VP, OP, ROPE, ALIBI>(cur, lds, wid); } }
}
struct DiffItems { int vcu, G; __device__ __forceinline__ int operator()(int i) const {
    if (G == 256) { if (i >= 4) return -1; const int xcd = vcu >> 5, w = vcu & 31; return ((xcd * 4 + i) * 4 + (w >> 3)) * 8 + (w & 7); }
    const int L = i * G + vcu; return L < 1024 ? L : -1; } };
struct MlaItems { int vcu, G, nvh; __device__ __forceinline__ int operator()(int i) const {
    const int tot = 256 * nvh;
    if (G == 256) { if (i >= nvh) return -1; const int xcd = vcu >> 5, w = vcu & 31;
        if (nvh == 2) return (((xcd * 4 + i * 2 + (w >> 4)) * 2) + ((w >> 3) & 1)) * 8 + (w & 7);
        return (xcd * 4 + (w >> 3)) * 8 + (w & 7); }
    const int L = i * G + vcu; return L < tot ? L : -1; } };

#ifndef MK_N_LAUNCHES
#define MK_N_LAUNCHES 1
#endif
constexpr int N_PHASES = 20;
constexpr int N_LAUNCHES = MK_N_LAUNCHES;
struct Args { In in; float* out; unsigned char* ws; int ph_lo, ph_hi, li, pad; };
__global__ void __launch_bounds__(NWAVES * 64, 2) mega_fwd(Args args) {
    extern __shared__ __attribute__((aligned(16))) unsigned char lds[];
    Frame F;
    F.lds = (LAS unsigned char*)lds; F.MISC = (volatile LAS unsigned*)(F.lds + MISC_OFF);
    F.wave = __builtin_amdgcn_readfirstlane((int)threadIdx.x >> 6);
    F.G = gridDim.x; { const int bx = blockIdx.x; F.vcu = (F.G % 8 == 0) ? (bx % 8) * (F.G / 8) + bx / 8 : bx; }
    F.ws = args.ws; F.ctl = (gu32*)(args.ws + WS_CTL);
    unsigned char* ws = args.ws; const In& in = args.in;
    for (int u = threadIdx.x; u < (LDS_BYTES - LDSCTL_OFF) / 4; u += NWAVES * 64) ((LAS unsigned*)(F.lds + LDSCTL_OFF))[u] = 0u;
    __syncthreads();
    XcdBarrier bar; bar.bar = (unsigned*)(F.ctl + CW_BAR); bar.x = 0; bar.st = nullptr;
    if (N_LAUNCHES == 1) bar = xcd_barrier_post((unsigned*)(F.ctl + CW_BAR), F.MISC + 8);
#define GRID_BAR() do { if (N_LAUNCHES == 1) xcd_barrier(bar, F.wave == 0 && lane_fresh() == 0); } while (0)
    const int lo = args.ph_lo, hi = args.ph_hi;
#ifndef PHASE_MASK
#define PHASE_MASK 0xFFFFFu
#endif
#ifndef DUP_MASK
#define DUP_MASK 0u
#endif
#define DUP_(k) ((((DUP_MASK) >> (k)) & 1u) != 0u)
#define IN_(k) ((((PHASE_MASK) >> (k)) & 1u) && lo <= (k) && (k) < hi)
#define SEAM(k) do { if (IN_(k) && IN_((k) + 1)) GRID_BAR(); } while (0)
    const float C2_MLA = 0.07216878364870322f * LOG2E, C2_DIFF = 0.08838834764831845f * LOG2E;
    typedef pg8::bf16_t pb;

    if (IN_(0)) { p0_prologue(F, in); } if (DUP_(0) && IN_(0)) { GRID_BAR(); { p0_prologue(F, in); } } SEAM(0);
    if (IN_(1)) { pg8::Gemm g{(const pb*)(ws + WS_HN), (const pb*)(ws + WS_WIN), NTOK, 4096, DM}; pg8::StaticOrder S; S.init(NTOK, 4096, F.G, (int)blockIdx.x);
        pg8::EpiBf16S E{(pb*)(ws + WS_ZIN), 4096, 0x7fffffff, 1 << 20, 0, 1.f};
        pg8::gemm_phase<pg8::EpiBf16S, pg8::StaticOrder, true, true>(F.lds + RING_OFF, g, S, E, F.wave); } if (DUP_(1) && IN_(1)) { GRID_BAR(); { pg8::Gemm g{(const pb*)(ws + WS_HN), (const pb*)(ws + WS_WIN), NTOK, 4096, DM}; pg8::StaticOrder S; S.init(NTOK, 4096, F.G, (int)blockIdx.x);
        pg8::EpiBf16S E{(pb*)(ws + WS_ZIN), 4096, 0x7fffffff, 1 << 20, 0, 1.f};
        pg8::gemm_phase<pg8::EpiBf16S, pg8::StaticOrder, true, true>(F.lds + RING_OFF, g, S, E, F.wave); } } SEAM(1);
    if (IN_(2)) { p2_even_local(F, in); } if (DUP_(2) && IN_(2)) { GRID_BAR(); { p2_even_local(F, in); } } SEAM(2);
    if (IN_(3)) {
        { pg8::Gemm g{(const pb*)(ws + WS_QL), (const pb*)(ws + WS_WUQ), NTOK, 1536, QRANK}; pg8::StaticOrder S; S.init(NTOK, 1536, F.G, (int)blockIdx.x);
          pg8::EpiQRope E{(pb*)(ws + WS_Q), 1536, (const float*)(ws + WS_ROPE), SEQ - 1, C2_MLA};
          pg8::gemm_phase<pg8::EpiQRope, pg8::StaticOrder, true, true>(F.lds + RING_OFF, g, S, E, F.wave); }
        { pg8::Gemm g{(const pb*)(ws + WS_KVL), (const pb*)(ws + WS_WUKV), NTOK, 2048, KVRANK}; pg8::StaticOrder S; S.init(NTOK, 2048, F.G, (int)blockIdx.x);
          pg8::EpiBf16S E{(pb*)(ws + WS_KNV), 2048, 0x7fffffff, 1 << 20, 0, 1.f, 128, 128, SEQ};
          pg8::gemm_phase<pg8::EpiBf16S, pg8::StaticOrder, true, true>(F.lds + RING_OFF, g, S, E, F.wave); } } if (DUP_(3) && IN_(3)) { GRID_BAR(); {
        { pg8::Gemm g{(const pb*)(ws + WS_QL), (const pb*)(ws + WS_WUQ), NTOK, 1536, QRANK}; pg8::StaticOrder S; S.init(NTOK, 1536, F.G, (int)blockIdx.x);
          pg8::EpiQRope E{(pb*)(ws + WS_Q), 1536, (const float*)(ws + WS_ROPE), SEQ - 1, C2_MLA};
          pg8::gemm_phase<pg8::EpiQRope, pg8::StaticOrder, true, true>(F.lds + RING_OFF, g, S, E, F.wave); }
        { pg8::Gemm g{(const pb*)(ws + WS_KVL), (const pb*)(ws + WS_WUKV), NTOK, 2048, KVRANK}; pg8::StaticOrder S; S.init(NTOK, 2048, F.G, (int)blockIdx.x);
          pg8::EpiBf16S E{(pb*)(ws + WS_KNV), 2048, 0x7fffffff, 1 << 20, 0, 1.f, 128, 128, SEQ};
          pg8::gemm_phase<pg8::EpiBf16S, pg8::StaticOrder, true, true>(F.lds + RING_OFF, g, S, E, F.wave); } } } SEAM(3);
    if (IN_(4)) { attn_phase<192, 128, 128, 2048, true, false>((char*)lds + RING_OFF, ws, MlaRef(), MlaItems{F.vcu, F.G, 4 / MLA_NDV}, F.wave); }
    if (DUP_(4) && IN_(4)) { GRID_BAR(); attn_phase<192, 128, 128, 2048, true, false>((char*)lds + RING_OFF, ws, MlaRef(), MlaItems{F.vcu, F.G, 4 / MLA_NDV}, F.wave); } SEAM(4);
    if (IN_(5)) { pg8::Gemm g{(const pb*)(ws + WS_CAT), (const pb*)(ws + WS_WO0), NTOK, DM, DM}; pg8::StaticOrder S; S.init(NTOK, DM, F.G, (int)blockIdx.x);
        pg8::EpiResBf16<true> E{in.p[0], (pb*)(ws + WS_XR), DM};
        pg8::gemm_phase<pg8::EpiResBf16<true>, pg8::StaticOrder, true, true>(F.lds + RING_OFF, g, S, E, F.wave); } if (DUP_(5) && IN_(5)) { GRID_BAR(); { pg8::Gemm g{(const pb*)(ws + WS_CAT), (const pb*)(ws + WS_WO0), NTOK, DM, DM}; pg8::StaticOrder S; S.init(NTOK, DM, F.G, (int)blockIdx.x);
        pg8::EpiResBf16<true> E{in.p[0], (pb*)(ws + WS_XR), DM};
        pg8::gemm_phase<pg8::EpiResBf16<true>, pg8::StaticOrder, true, true>(F.lds + RING_OFF, g, S, E, F.wave); } } SEAM(5);
    if (IN_(6)) { p6_route(F, in.p[9], in.p[11], in.p[13], ws + WS_WR0); } if (DUP_(6) && IN_(6)) { GRID_BAR(); { p6_route(F, in.p[9], in.p[11], in.p[13], ws + WS_WR0); } } SEAM(6);
    if (IN_(7)) { p7_dispatch(F, in.p[9]); } if (DUP_(7) && IN_(7)) { GRID_BAR(); { p7_dispatch(F, in.p[9]); } } SEAM(7);
    if (IN_(8)) { const int* mo = (const int*)(ws + WS_MOE); pg8::Gemm g{(const pb*)(ws + WS_AP), (const pb*)(ws + WS_WUP0), 0, 0, DM}; pg8::GroupedOrder S; S.init(mo + MO_TILEE, mo[MO_NTILE], 4, F.G, (int)blockIdx.x);
        pg8::EpiSwiGLU E{(pb*)(ws + WS_HS)};
        pg8::gemm_phase<pg8::EpiSwiGLU, pg8::GroupedOrder, true, true>(F.lds + RING_OFF, g, S, E, F.wave); } if (DUP_(8) && IN_(8)) { GRID_BAR(); { const int* mo = (const int*)(ws + WS_MOE); pg8::Gemm g{(const pb*)(ws + WS_AP), (const pb*)(ws + WS_WUP0), 0, 0, DM}; pg8::GroupedOrder S; S.init(mo + MO_TILEE, mo[MO_NTILE], 4, F.G, (int)blockIdx.x);
        pg8::EpiSwiGLU E{(pb*)(ws + WS_HS)};
        pg8::gemm_phase<pg8::EpiSwiGLU, pg8::GroupedOrder, true, true>(F.lds + RING_OFF, g, S, E, F.wave); } } SEAM(8);
    if (IN_(9)) { const int* mo = (const int*)(ws + WS_MOE); pg8::Gemm g{(const pb*)(ws + WS_HS), (const pb*)(ws + WS_WDN0), 0, 0, EFF}; pg8::GroupedOrder S; S.init(mo + MO_TILEE, mo[MO_NTILE], 8, F.G, (int)blockIdx.x);
        pg8::EpiBf16S E{(pb*)(ws + WS_Y), DM, 7, 1 << 20, 0, 1.f};
        pg8::gemm_phase<pg8::EpiBf16S, pg8::GroupedOrder, true, true>(F.lds + RING_OFF, g, S, E, F.wave); } if (DUP_(9) && IN_(9)) { GRID_BAR(); { const int* mo = (const int*)(ws + WS_MOE); pg8::Gemm g{(const pb*)(ws + WS_HS), (const pb*)(ws + WS_WDN0), 0, 0, EFF}; pg8::GroupedOrder S; S.init(mo + MO_TILEE, mo[MO_NTILE], 8, F.G, (int)blockIdx.x);
        pg8::EpiBf16S E{(pb*)(ws + WS_Y), DM, 7, 1 << 20, 0, 1.f};
        pg8::gemm_phase<pg8::EpiBf16S, pg8::GroupedOrder, true, true>(F.lds + RING_OFF, g, S, E, F.wave); } } SEAM(9);
    if (IN_(10)) { p10_combine<false>(F, in.p[16], nullptr); } SEAM(10);
    if (IN_(11)) { pg8::Gemm g{(const pb*)(ws + WS_HN), (const pb*)(ws + WS_WQKV), NTOK, 6144, DM}; pg8::StaticOrder S; S.init(NTOK, 6144, F.G, (int)blockIdx.x);
        pg8::EpiBf16S E{(pb*)(ws + WS_Q1), DM, 0x7fffffff, 8, (size_t)(WS_K1 - WS_Q1) / 2, C2_DIFF, 128, 256, SEQ};
        pg8::gemm_phase<pg8::EpiBf16S, pg8::StaticOrder, true, true>(F.lds + RING_OFF, g, S, E, F.wave); } if (DUP_(11) && IN_(11)) { GRID_BAR(); { pg8::Gemm g{(const pb*)(ws + WS_HN), (const pb*)(ws + WS_WQKV), NTOK, 6144, DM}; pg8::StaticOrder S; S.init(NTOK, 6144, F.G, (int)blockIdx.x);
        pg8::EpiBf16S E{(pb*)(ws + WS_Q1), DM, 0x7fffffff, 8, (size_t)(WS_K1 - WS_Q1) / 2, C2_DIFF, 128, 256, SEQ};
        pg8::gemm_phase<pg8::EpiBf16S, pg8::StaticOrder, true, true>(F.lds + RING_OFF, g, S, E, F.wave); } } SEAM(11);
    if (IN_(12)) { attn_phase<128, 128, 256, 256, false, true>((char*)lds + RING_OFF, ws, DiffRef(), DiffItems{F.vcu, F.G}, F.wave); }
    if (DUP_(12) && IN_(12)) { GRID_BAR(); attn_phase<128, 128, 256, 256, false, true>((char*)lds + RING_OFF, ws, DiffRef(), DiffItems{F.vcu, F.G}, F.wave); } SEAM(12);
    if (IN_(13)) { p13_diff_combine(F, in); } if (DUP_(13) && IN_(13)) { GRID_BAR(); { p13_diff_combine(F, in); } } SEAM(13);
    if (IN_(14)) { pg8::Gemm g{(const pb*)(ws + WS_ATT), (const pb*)(ws + WS_WO1), NTOK, DM, DM}; pg8::StaticOrder S; S.init(NTOK, DM, F.G, (int)blockIdx.x);
        pg8::EpiResBf16<false> E{(const void*)(ws + WS_XR), (pb*)(ws + WS_XR), DM};
        pg8::gemm_phase<pg8::EpiResBf16<false>, pg8::StaticOrder, true, true>(F.lds + RING_OFF, g, S, E, F.wave); } SEAM(14);
    if (IN_(15)) { p6_route(F, in.p[24], in.p[26], in.p[28], ws + WS_WR1); } if (DUP_(15) && IN_(15)) { GRID_BAR(); { p6_route(F, in.p[24], in.p[26], in.p[28], ws + WS_WR1); } } SEAM(15);
    if (IN_(16)) { p7_dispatch(F, in.p[24]); } if (DUP_(16) && IN_(16)) { GRID_BAR(); { p7_dispatch(F, in.p[24]); } } SEAM(16);
    if (IN_(17)) { const int* mo = (const int*)(ws + WS_MOE); pg8::Gemm g{(const pb*)(ws + WS_AP), (const pb*)(ws + WS_WUP1), 0, 0, DM}; pg8::GroupedOrder S; S.init(mo + MO_TILEE, mo[MO_NTILE], 4, F.G, (int)blockIdx.x);
        pg8::EpiSwiGLU E{(pb*)(ws + WS_HS)};
        pg8::gemm_phase<pg8::EpiSwiGLU, pg8::GroupedOrder, true, true>(F.lds + RING_OFF, g, S, E, F.wave); } if (DUP_(17) && IN_(17)) { GRID_BAR(); { const int* mo = (const int*)(ws + WS_MOE); pg8::Gemm g{(const pb*)(ws + WS_AP), (const pb*)(ws + WS_WUP1), 0, 0, DM}; pg8::GroupedOrder S; S.init(mo + MO_TILEE, mo[MO_NTILE], 4, F.G, (int)blockIdx.x);
        pg8::EpiSwiGLU E{(pb*)(ws + WS_HS)};
        pg8::gemm_phase<pg8::EpiSwiGLU, pg8::GroupedOrder, true, true>(F.lds + RING_OFF, g, S, E, F.wave); } } SEAM(17);
    if (IN_(18)) { const int* mo = (const int*)(ws + WS_MOE); pg8::Gemm g{(const pb*)(ws + WS_HS), (const pb*)(ws + WS_WDN1), 0, 0, EFF}; pg8::GroupedOrder S; S.init(mo + MO_TILEE, mo[MO_NTILE], 8, F.G, (int)blockIdx.x);
        pg8::EpiBf16S E{(pb*)(ws + WS_Y), DM, 7, 1 << 20, 0, 1.f};
        pg8::gemm_phase<pg8::EpiBf16S, pg8::GroupedOrder, true, true>(F.lds + RING_OFF, g, S, E, F.wave); } if (DUP_(18) && IN_(18)) { GRID_BAR(); { const int* mo = (const int*)(ws + WS_MOE); pg8::Gemm g{(const pb*)(ws + WS_HS), (const pb*)(ws + WS_WDN1), 0, 0, EFF}; pg8::GroupedOrder S; S.init(mo + MO_TILEE, mo[MO_NTILE], 8, F.G, (int)blockIdx.x);
        pg8::EpiBf16S E{(pb*)(ws + WS_Y), DM, 7, 1 << 20, 0, 1.f};
        pg8::gemm_phase<pg8::EpiBf16S, pg8::GroupedOrder, true, true>(F.lds + RING_OFF, g, S, E, F.wave); } } SEAM(18);
    if (IN_(19)) { p10_combine<true>(F, in.p[31], args.out); }
#undef IN_
#undef SEAM
#undef GRID_BAR
}

extern "C" void kernel_launch(void* const* d_in, const int* in_sizes, int n_in, void* d_out, int out_size, void* d_ws, size_t ws_size, hipStream_t stream) {
    static int grid = 0;
    if (grid == 0) {
        if (n_in != 32 || in_sizes[0] != NTOK * DM || out_size != NTOK * DM || ws_size < WS_END) { fprintf(stderr, "kernel_launch: unexpected shapes: n_in %d in0 %d out %d ws %zu; nothing launched\n", n_in, n_in > 0 ? in_sizes[0] : -1, out_size, ws_size); grid = -1; return; }
        int dev = 0, cus = 0, per_cu = 0;
        if (hipGetDevice(&dev) != hipSuccess || hipDeviceGetAttribute(&cus, hipDeviceAttributeMultiprocessorCount, dev) != hipSuccess) { fprintf(stderr, "kernel_launch: device query failed\n"); grid = -1; return; }
        if (hipFuncSetAttribute((const void*)mega_fwd, hipFuncAttributeMaxDynamicSharedMemorySize, LDS_BYTES) != hipSuccess) { fprintf(stderr, "kernel_launch: hipFuncSetAttribute failed\n"); grid = -1; return; }
        if (hipOccupancyMaxActiveBlocksPerMultiprocessor(&per_cu, (const void*)mega_fwd, NWAVES * 64, LDS_BYTES) != hipSuccess || per_cu < 1)
            fprintf(stderr, "kernel_launch: note: occupancy query reports %d workgroups per CU\n", per_cu);
        (void)hipGetLastError();
        grid = cus;
    }
    if (grid < 0) return;
    if (hipMemsetAsync((char*)d_ws + WS_CTL, 0, CTL_ZERO_BYTES, stream) != hipSuccess) { fprintf(stderr, "kernel_launch: memset failed\n"); return; }
    Args a{};
    for (int i = 0; i < 32; ++i) a.in.p[i] = (const float*)d_in[i];
    a.out = (float*)d_out; a.ws = (unsigned char*)d_ws;
    for (int li = 0; li < N_LAUNCHES; ++li) {
        a.ph_lo = (N_LAUNCHES == 1) ? 0 : li; a.ph_hi = (N_LAUNCHES == 1) ? N_PHASES : li + 1; a.li = li;
        hipLaunchKernelGGL(mega_fwd, dim3(grid), dim3(NWAVES * 64), LDS_BYTES, stream, a);
        const hipError_t le = hipPeekAtLastError();
        if (le != hipSuccess) { fprintf(stderr, "kernel_launch: launch %d failed: %s\n", li, hipGetErrorName(le)); break; }
    }
}
```

```cpp
#include <hip/hip_runtime.h>
#include <cstdio>
#include <cstdint>
#include <cmath>

constexpr int NB = 4, SEQ = 4096, DM = 2048, NTOK = NB * SEQ;
constexpr int CONVW = 1024, MLA_H = 8, QRANK = 512, KVRANK = 256;
constexpr int EVEN_IN = 3 * CONVW + QRANK + KVRANK + 64;
constexpr int DH = 8;
constexpr int NEXP = 32, EFF = 512;
constexpr float EPS = 1e-6f;
constexpr float LAM_INIT = 0.35550906759f;


__device__ __forceinline__ int lane_fresh() { int l; asm volatile("v_mbcnt_lo_u32_b32 %0, -1, 0\n\tv_mbcnt_hi_u32_b32 %0, -1, %0" : "=v"(l)); return l; }
namespace pg8 {
#define PG8_LAS __attribute__((address_space(3)))
typedef unsigned short bf16_t;
typedef short bf16x8 __attribute__((ext_vector_type(8)));
typedef float f32x4 __attribute__((ext_vector_type(4)));
typedef unsigned u32x4 __attribute__((ext_vector_type(4)));
constexpr int BM = 256, BK = 64, HALF = 128, HTB = HALF * BK * 2  , STAGE_BYTES = 8 * HTB, NXCD = 8, WGM = 8;

__host__ __device__ __forceinline__ int lds_byte(int r, int c) { const int st = (r >> 4) * 2 + (c >> 5), rr = r & 15, cc = c & 31, ob = rr * 64 + cc * 2; return st * 1024 + (ob ^ (((ob >> 9) & 1) << 5)); }
__host__ __device__ __forceinline__ void stage_rc(int b, int& R, int& C) { const int st = b / 1024, sb = b % 1024, swz = sb ^ (((sb >> 9) & 1) << 5); R = (st >> 1) * 16 + swz / 64; C = (st & 1) * 32 + (swz % 64) / 2; }
__host__ __device__ __forceinline__ int perm32(int rho) { const int n = rho >> 4, i = rho & 15; return 8 * (i >> 2) + 4 * n + (i & 3); }

struct Unit { int pm, pn; };
struct Gemm { const bf16_t* A; const bf16_t* Bt; int M, N, K; };

struct StaticOrder {
    int nM, nN, nwg, G, c;
    __host__ __device__ void init(int M, int N, int G_, int c_) { nM = M / BM; nN = N / BM; nwg = nM * nN; G = G_; c = c_; }
    __host__ __device__ bool next(int i, Unit& u) const {
        const long L = (long)i * G + c; if (L >= nwg) return false;
        int wgid = (int)L; { const int q = nwg / NXCD, r = nwg % NXCD, xcd = wgid % NXCD, off = wgid / NXCD; wgid = (xcd < r ? xcd * (q + 1) : r * (q + 1) + (xcd - r) * q) + off; }
        const int nig = WGM * nN, gid = wgid / nig, fm = gid * WGM, gsz = (nM - fm) < WGM ? (nM - fm) : WGM;
        u.pm = fm + ((wgid % nig) % gsz); u.pn = (wgid % nig) / gsz; return true;
    }
    __device__ __forceinline__ void a_ready(const Unit&) const {}
    __device__ __forceinline__ void done(const Unit&) const {}
};

__device__ __forceinline__ unsigned cvt_pk_bf16(float lo, float hi) { unsigned r; asm volatile("v_cvt_pk_bf16_f32 %0, %1, %2" : "=v"(r) : "v"(lo), "v"(hi)); return r; }
typedef float f32x2 __attribute__((ext_vector_type(2)));

struct GroupedOrder {
    const int* tile_e; int NCT, nun, G, c;
    __device__ __forceinline__ void init(const int* te, int ntile, int nct, int G_, int c_) { tile_e = te; NCT = nct; nun = ntile * nct; G = G_; c = c_; }
    __device__ __forceinline__ bool next(int i, Unit& u) const {
        const int L = i * G + c; if (L >= nun) return false;
        const int pt = L / NCT, nt = L - pt * NCT; const int e = __builtin_amdgcn_readfirstlane(tile_e[pt]);
        u.pm = pt; u.pn = e * NCT + nt; return true;
    }
    __device__ __forceinline__ void a_ready(const Unit&) const {}
    __device__ __forceinline__ void done(const Unit&) const {}
};
struct EpiBf16S {
    static constexpr bool PERM = true, AFTER_DRAIN = false;
    bf16_t* O; int ldc; int pnmask; int ncs; size_t split_stride; float scale0;
    int hmw01 = 0, hmw2 = 0, seq = 1;
    __device__ __forceinline__ void operator()(const f32x4 (&acc)[2][2][4][2], const Unit& u, int wr, int wc, int fr, int fq) const {
        const int t = u.pn & pnmask, s = t / ncs; bf16_t* base = O + (size_t)s * split_stride; const float sc = (s == 0) ? scale0 : 1.f;
        const int row0 = u.pm * BM + wr * 64 + fr, col0 = (t - s * ncs) * BM + wc * 32 + 8 * fq;
        const int hmw = (s < 2) ? hmw01 : hmw2;
#pragma unroll
        for (int ai = 0; ai < 2; ++ai)
#pragma unroll
            for (int m = 0; m < 4; ++m) { const int row = row0 + ai * HALF + m * 16;
#pragma unroll
                for (int bj = 0; bj < 2; ++bj) { const f32x4 v0 = acc[ai][bj][m][0] * sc, v1 = acc[ai][bj][m][1] * sc; const int col = col0 + bj * HALF;
                    bf16_t* p;
                    if (hmw) { const int b = row / seq, tt = row - b * seq, hd = col / hmw, d = col - hd * hmw; p = base + ((size_t)(b * (ldc / hmw) + hd) * seq + tt) * hmw + d; }
                    else p = base + (size_t)row * ldc + col;
                    u32x4 w; w.x = cvt_pk_bf16(v0[0], v0[1]); w.y = cvt_pk_bf16(v0[2], v0[3]); w.z = cvt_pk_bf16(v1[0], v1[1]); w.w = cvt_pk_bf16(v1[2], v1[3]);
                    *(u32x4*)p = w; } }
    }
};
struct EpiQRope {
    static constexpr bool PERM = true, AFTER_DRAIN = false;
    bf16_t* O; int ldc; const float* tab; int seqmask; float scale;
    __device__ __forceinline__ void operator()(const f32x4 (&acc)[2][2][4][2], const Unit& u, int wr, int wc, int fr, int fq) const {
        const int row0 = u.pm * BM + wr * 64 + fr, col0 = u.pn * BM + wc * 32 + 8 * fq;
#pragma unroll
        for (int ai = 0; ai < 2; ++ai)
#pragma unroll
            for (int m = 0; m < 4; ++m) { const int row = row0 + ai * HALF + m * 16; const int tpos = row & seqmask, bidx = row / (seqmask + 1);
#pragma unroll
                for (int bj = 0; bj < 2; ++bj) { f32x4 v0 = acc[ai][bj][m][0], v1 = acc[ai][bj][m][1];
                    const int col = col0 + bj * HALF, d = col % 192;
                    if (d >= 128) { const float* tp = tab + ((size_t)tpos * 32 + ((d - 128) >> 1)) * 2; const f32x4 c0 = *(const f32x4*)tp, c1 = *(const f32x4*)(tp + 4);
                        f32x4 r0, r1;
                        r0[0] = v0[0] * c0[0] - v0[1] * c0[1]; r0[1] = v0[0] * c0[1] + v0[1] * c0[0]; r0[2] = v0[2] * c0[2] - v0[3] * c0[3]; r0[3] = v0[2] * c0[3] + v0[3] * c0[2];
                        r1[0] = v1[0] * c1[0] - v1[1] * c1[1]; r1[1] = v1[0] * c1[1] + v1[1] * c1[0]; r1[2] = v1[2] * c1[2] - v1[3] * c1[3]; r1[3] = v1[2] * c1[3] + v1[3] * c1[2];
                        v0 = r0; v1 = r1; }
                    v0 = v0 * scale; v1 = v1 * scale;
                    u32x4 w; w.x = cvt_pk_bf16(v0[0], v0[1]); w.y = cvt_pk_bf16(v0[2], v0[3]); w.z = cvt_pk_bf16(v1[0], v1[1]); w.w = cvt_pk_bf16(v1[2], v1[3]);
                    *(u32x4*)(O + ((size_t)(bidx * (ldc / 192) + col / 192) * (seqmask + 1) + tpos) * 192 + d) = w; } }
    }
};
struct EpiF32Res {
    static constexpr bool PERM = false, AFTER_DRAIN = false;
    const float* R; float* C; int ldc;
    __device__ __forceinline__ void operator()(const f32x4 (&acc)[2][2][4][2], const Unit& u, int wr, int wc, int fr, int fq) const {
        const int row0 = u.pm * BM + wr * 64 + fr, col0 = u.pn * BM + wc * 32 + 4 * fq;
#pragma unroll
        for (int ai = 0; ai < 2; ++ai)
#pragma unroll
            for (int m = 0; m < 4; ++m) { const size_t off = (size_t)(row0 + ai * HALF + m * 16) * ldc + col0;
#pragma unroll
                for (int bj = 0; bj < 2; ++bj)
#pragma unroll
                    for (int n = 0; n < 2; ++n) { const f32x4 r = *(const f32x4*)(R + off + bj * HALF + n * 16); *(f32x4*)(C + off + bj * HALF + n * 16) = acc[ai][bj][m][n] + r; } }
    }
};
template <bool RF32> struct EpiResBf16 {
    static constexpr bool PERM = true, AFTER_DRAIN = false;
    const void* R; bf16_t* C; int ldc;
    __device__ __forceinline__ void operator()(const f32x4 (&acc)[2][2][4][2], const Unit& u, int wr, int wc, int fr, int fq) const {
        const int row0 = u.pm * BM + wr * 64 + fr, col0 = u.pn * BM + wc * 32 + 8 * fq;
#pragma unroll
        for (int ai = 0; ai < 2; ++ai)
#pragma unroll
            for (int m = 0; m < 4; ++m) { const size_t off = (size_t)(row0 + ai * HALF + m * 16) * ldc + col0;
#pragma unroll
                for (int bj = 0; bj < 2; ++bj) { f32x4 v0 = acc[ai][bj][m][0], v1 = acc[ai][bj][m][1]; const size_t o = off + bj * HALF;
                    if constexpr (RF32) { v0 = v0 + *(const f32x4*)((const float*)R + o); v1 = v1 + *(const f32x4*)((const float*)R + o + 4); }
                    else { const u32x4 r = *(const u32x4*)((const bf16_t*)R + o);
                        v0[0] += __uint_as_float(r.x << 16); v0[1] += __uint_as_float(r.x & 0xffff0000u); v0[2] += __uint_as_float(r.y << 16); v0[3] += __uint_as_float(r.y & 0xffff0000u);
                        v1[0] += __uint_as_float(r.z << 16); v1[1] += __uint_as_float(r.z & 0xffff0000u); v1[2] += __uint_as_float(r.w << 16); v1[3] += __uint_as_float(r.w & 0xffff0000u); }
                    u32x4 w; w.x = cvt_pk_bf16(v0[0], v0[1]); w.y = cvt_pk_bf16(v0[2], v0[3]); w.z = cvt_pk_bf16(v1[0], v1[1]); w.w = cvt_pk_bf16(v1[2], v1[3]);
                    *(u32x4*)(C + o) = w; } }
    }
};
struct EpiSwiGLU {
    static constexpr bool PERM = true, AFTER_DRAIN = false;
    bf16_t* O;
    __device__ __forceinline__ void operator()(const f32x4 (&acc)[2][2][4][2], const Unit& u, int wr, int wc, int fr, int fq) const {
        const int nt = u.pn & 3; const int row0 = u.pm * BM + wr * 64 + fr, col0 = nt * 128 + wc * 32 + 8 * fq;
#pragma unroll
        for (int ai = 0; ai < 2; ++ai)
#pragma unroll
            for (int m = 0; m < 4; ++m) { bf16_t* rowp = O + (size_t)(row0 + ai * HALF + m * 16) * 512 + col0; float h[8];
#pragma unroll
                for (int n = 0; n < 2; ++n)
#pragma unroll
                    for (int i = 0; i < 4; ++i) { const float g = acc[ai][0][m][n][i], up = acc[ai][1][m][n][i];
                        h[4 * n + i] = g * __builtin_amdgcn_rcpf(1.f + __builtin_amdgcn_exp2f(-1.4426950408889634f * g)) * up; }
                u32x4 w; w.x = cvt_pk_bf16(h[0], h[1]); w.y = cvt_pk_bf16(h[2], h[3]); w.z = cvt_pk_bf16(h[4], h[5]); w.w = cvt_pk_bf16(h[6], h[7]);
                *(u32x4*)rowp = w; }
    }
};

template <class Epi, class Sched, bool ALIGN_EPI = false, bool SP2 = false>
__device__ __forceinline__ void gemm_phase(PG8_LAS unsigned char* lds, const Gemm g, const Sched& S, const Epi& E, const int wid) {
    const int lane = lane_fresh(), tid = wid * 64 + lane, wr = wid >> 2, wc = wid & 3, fr = lane & 15, fq = lane >> 4;
    const int K = g.K, nt = K / BK;
    unsigned voffA[2], voffB[2];
#pragma unroll
    for (int i = 0; i < 2; ++i) { int R, C; stage_rc(tid * 16 + i * 8192, R, C); const int Rb = Epi::PERM ? ((R & ~31) + perm32(R & 31)) : R;
        voffA[i] = (unsigned)(R * K + C) * 2u; voffB[i] = (unsigned)(Rb * K + C) * 2u; }
    const size_t kstep = (size_t)(BK * 2);
    const size_t hstep = (size_t)HALF * K * 2;
    const size_t tstep = 2 * hstep;
    const unsigned ldsw = (unsigned)wid * 1024u;
    const int aoff = lds_byte(wr * 64 + fr, fq * 8), boff = lds_byte(wc * 32 + fr, fq * 8);
#define PG8_SA(b, h) (((b) * 2 + (h)) * HTB)
#define PG8_SB(b, h) ((4 + (b) * 2 + (h)) * HTB)
#define PG8_STAGE(bufoff, gbase, voff) do { _Pragma("unroll") for (int _i = 0; _i < 2; ++_i) \
        __builtin_amdgcn_global_load_lds((const unsigned*)((const char*)(gbase) + (voff)[_i]), (PG8_LAS unsigned*)(lds + (bufoff) + ldsw + _i * 8192), 16, 0, 0); } while (0)
#define PG8_LDA(dst, b, h) do { _Pragma("unroll") for (int m = 0; m < 4; ++m) _Pragma("unroll") for (int k = 0; k < 2; ++k) dst[m][k] = *(const PG8_LAS bf16x8*)(lds + PG8_SA(b, h) + aoff + m * 2048 + k * 1024); } while (0)
#define PG8_LDB(dst, b, h) do { _Pragma("unroll") for (int n = 0; n < 2; ++n) _Pragma("unroll") for (int k = 0; k < 2; ++k) dst[n][k] = *(const PG8_LAS bf16x8*)(lds + PG8_SB(b, h) + boff + n * 2048 + k * 1024); } while (0)
#define PG8_MMA(ai, bj, At, Bt) do { __builtin_amdgcn_s_setprio(1); _Pragma("unroll") for (int m = 0; m < 4; ++m) _Pragma("unroll") for (int n = 0; n < 2; ++n) _Pragma("unroll") for (int k = 0; k < 2; ++k) \
        acc[ai][bj][m][n] = __builtin_amdgcn_mfma_f32_16x16x32_bf16(Bt[n][k], At[m][k], acc[ai][bj][m][n], 0, 0, 0); __builtin_amdgcn_s_setprio(0); } while (0)
#define PG8_WAIT_V(n) asm volatile("s_waitcnt vmcnt(" #n ")" ::: "memory")
#define PG8_WAIT_L(n) asm volatile("s_waitcnt lgkmcnt(" #n ")" ::: "memory")
#define PG8_BAR __builtin_amdgcn_s_barrier()
#define PG8_SCHED __builtin_amdgcn_sched_barrier(0)
    Unit cur, nxt; int ui = 0;
    if (!S.next(0, cur)) return;
    f32x4 acc[2][2][4][2];
#pragma unroll
    for (int a = 0; a < 2; ++a)
#pragma unroll
        for (int b = 0; b < 2; ++b)
#pragma unroll
            for (int m = 0; m < 4; ++m)
#pragma unroll
                for (int n = 0; n < 2; ++n) acc[a][b][m][n] = (f32x4){0.f, 0.f, 0.f, 0.f};
    bf16x8 At[4][2], B0[2][2], B1[2][2];
    const char* cA = (const char*)g.A + (size_t)cur.pm * tstep; const char* cB = (const char*)g.Bt + (size_t)cur.pn * tstep;
    S.a_ready(cur);
    if constexpr (SP2) {
        PG8_STAGE(PG8_SB(0, 0), cB, voffB); PG8_STAGE(PG8_SB(0, 1), cB + hstep, voffB); PG8_STAGE(PG8_SA(0, 0), cA, voffA); PG8_STAGE(PG8_SA(0, 1), cA + hstep, voffA);
        if (wr == 1) PG8_BAR;
        PG8_WAIT_V(2); PG8_BAR;
        PG8_STAGE(PG8_SB(1, 0), cB + kstep, voffB); PG8_STAGE(PG8_SA(1, 0), cA + kstep, voffA); PG8_STAGE(PG8_SB(1, 1), cB + hstep + kstep, voffB);
        PG8_WAIT_V(6); PG8_BAR;
    } else {
        PG8_STAGE(PG8_SB(0, 0), cB, voffB); PG8_STAGE(PG8_SA(0, 0), cA, voffA); PG8_STAGE(PG8_SB(0, 1), cB + hstep, voffB); PG8_STAGE(PG8_SA(0, 1), cA + hstep, voffA);
        if (wr == 1) PG8_BAR;
        PG8_WAIT_V(4); PG8_BAR;
        PG8_STAGE(PG8_SB(1, 0), cB + kstep, voffB); PG8_STAGE(PG8_SA(1, 0), cA + kstep, voffA); PG8_STAGE(PG8_SB(1, 1), cB + hstep + kstep, voffB);
        PG8_WAIT_V(6); PG8_BAR;
    }
    for (;;) {
        const bool has_next = S.next(ui + 1, nxt);
        const char* nA = has_next ? (const char*)g.A + (size_t)nxt.pm * tstep : cA; const char* nB = has_next ? (const char*)g.Bt + (size_t)nxt.pn * tstep : cB;
        for (int t = 0; t < nt; t += 2) {
            const bool last = (t == nt - 2);
            const char* a1 = cA + (size_t)(t + 1) * kstep;
            const char* a2 = last ? nA : cA + (size_t)(t + 2) * kstep; const char* b2 = last ? nB : cB + (size_t)(t + 2) * kstep;
            const char* a3 = a2 + kstep; const char* b3 = b2 + kstep;
            if (last && has_next) S.a_ready(nxt);
            if constexpr (SP2) {
            PG8_LDB(B0, 0, 0); PG8_LDB(B1, 0, 1); PG8_SCHED; PG8_LDA(At, 0, 0); PG8_STAGE(PG8_SA(1, 1), a1 + hstep, voffA);
            PG8_WAIT_V(8); PG8_WAIT_L(0); PG8_BAR; PG8_MMA(0, 0, At, B0); PG8_MMA(0, 1, At, B1); PG8_BAR; PG8_SCHED;
            PG8_LDA(At, 0, 1); PG8_STAGE(PG8_SB(0, 0), b2, voffB); PG8_STAGE(PG8_SB(0, 1), b2 + hstep, voffB); PG8_STAGE(PG8_SA(0, 0), a2, voffA);
            PG8_WAIT_V(8); PG8_WAIT_L(0); PG8_BAR; PG8_MMA(1, 0, At, B0); PG8_MMA(1, 1, At, B1); PG8_BAR; PG8_SCHED;
            PG8_LDB(B0, 1, 0); PG8_LDB(B1, 1, 1); PG8_SCHED; PG8_LDA(At, 1, 0); PG8_STAGE(PG8_SA(0, 1), a2 + hstep, voffA);
            PG8_WAIT_V(8); PG8_WAIT_L(0); PG8_BAR; PG8_MMA(0, 0, At, B0); PG8_MMA(0, 1, At, B1); PG8_BAR; PG8_SCHED;
            PG8_LDA(At, 1, 1); PG8_STAGE(PG8_SB(1, 0), b3, voffB); PG8_STAGE(PG8_SB(1, 1), b3 + hstep, voffB); PG8_STAGE(PG8_SA(1, 0), a3, voffA);
            PG8_WAIT_V(8); PG8_WAIT_L(0); PG8_BAR; PG8_MMA(1, 0, At, B0); PG8_MMA(1, 1, At, B1); PG8_BAR; PG8_SCHED;
            } else {
            PG8_LDB(B0, 0, 0); PG8_SCHED; PG8_LDA(At, 0, 0); PG8_STAGE(PG8_SA(1, 1), a1 + hstep, voffA);
            PG8_WAIT_L(8); PG8_BAR; PG8_WAIT_L(0); PG8_MMA(0, 0, At, B0); PG8_BAR; PG8_SCHED;
            PG8_LDB(B1, 0, 1); PG8_STAGE(PG8_SB(0, 0), b2, voffB);
            PG8_BAR; PG8_WAIT_L(0); PG8_MMA(0, 1, At, B1); PG8_BAR;
            PG8_LDA(At, 0, 1); PG8_STAGE(PG8_SA(0, 0), a2, voffA);
            PG8_BAR; PG8_WAIT_L(0); PG8_MMA(1, 0, At, B0); PG8_BAR; PG8_SCHED;
            PG8_STAGE(PG8_SB(0, 1), b2 + hstep, voffB);
            PG8_WAIT_V(6); PG8_BAR; PG8_MMA(1, 1, At, B1); PG8_BAR;
            PG8_LDB(B0, 1, 0); PG8_SCHED; PG8_LDA(At, 1, 0); PG8_STAGE(PG8_SA(0, 1), a2 + hstep, voffA);
            PG8_WAIT_L(8); PG8_BAR; PG8_WAIT_L(0); PG8_MMA(0, 0, At, B0); PG8_BAR; PG8_SCHED;
            PG8_LDB(B1, 1, 1); PG8_STAGE(PG8_SB(1, 0), b3, voffB);
            PG8_BAR; PG8_WAIT_L(0); PG8_MMA(0, 1, At, B1); PG8_BAR;
            PG8_LDA(At, 1, 1); PG8_STAGE(PG8_SA(1, 0), a3, voffA);
            PG8_BAR; PG8_WAIT_L(0); PG8_MMA(1, 0, At, B0); PG8_BAR; PG8_SCHED;
            PG8_STAGE(PG8_SB(1, 1), b3 + hstep, voffB);
            PG8_WAIT_V(6); PG8_BAR; PG8_MMA(1, 1, At, B1); PG8_BAR;
            }
        }
        if constexpr (ALIGN_EPI) { if (wr == 0) PG8_BAR; }
        if constexpr (!Epi::AFTER_DRAIN) { E(acc, cur, wr, wc, fr, fq); S.done(cur); }
        if (!has_next) break;
#pragma unroll
        for (int a = 0; a < 2; ++a)
#pragma unroll
            for (int b = 0; b < 2; ++b)
#pragma unroll
                for (int m = 0; m < 4; ++m)
#pragma unroll
                    for (int n = 0; n < 2; ++n) acc[a][b][m][n] = (f32x4){0.f, 0.f, 0.f, 0.f};
        cur = nxt; cA = nA; cB = nB; ++ui;
        if constexpr (ALIGN_EPI) { if (wr == 1) PG8_BAR; }
    }
    PG8_WAIT_V(0);
    if constexpr (!ALIGN_EPI) { if (wr == 0) PG8_BAR; }
    PG8_BAR;
    if constexpr (Epi::AFTER_DRAIN) { E.fused(acc, cur, wr, wc, fr, fq, lds, wid, lane); S.done(cur); }
#undef PG8_SA
#undef PG8_SB
#undef PG8_STAGE
#undef PG8_LDA
#undef PG8_LDB
#undef PG8_MMA
#undef PG8_WAIT_V
#undef PG8_WAIT_L
#undef PG8_BAR
#undef PG8_SCHED
}
}

namespace att {
typedef unsigned short bf16;
typedef short bf16x8 __attribute__((ext_vector_type(8)));
typedef short s16x4 __attribute__((ext_vector_type(4)));
typedef float f32x16 __attribute__((ext_vector_type(16)));
typedef float f32x4 __attribute__((ext_vector_type(4)));
typedef unsigned u32x4 __attribute__((ext_vector_type(4)));
constexpr int NW = 8, QBLK = 32, KVBLK = 64, QB = NW * QBLK;
constexpr int SHM_V = KVBLK * 128 * 2, SHM_K = KVBLK * 128 * 2, SHM_K2 = KVBLK * 64 * 2;
constexpr int LDS_BYTES = 3 * (SHM_K + SHM_V + SHM_K2) + NW * 4096;
#define OFF_K 0
#define OFF_V (NS * SHM_K)
#define OFF_K2 (NS * (SHM_K + SHM_V))
#define OFF_QR (NS * (SHM_K + SHM_V + SHM_K2))
constexpr float THR2 = 11.5416f;
#define KSWZ(row, colB) ((row) * 256 + ((colB) ^ (((row) & 15) << 4)))
#define K2SWZ(row, colB) ((row) * 128 + ((colB) ^ ((((row) >> 1) & 7) << 4)))
#define SBAR() __builtin_amdgcn_sched_barrier(0)
__device__ __forceinline__ int v_st(int k, int c) { const int kk = (k & ~0xC) | ((k & 4) << 1) | ((k & 8) >> 1); return ((kk >> 3) * 4 + (c >> 5)) * 512 + ((kk & 7) * 32 + (c & 31)) * 2; }
__device__ __forceinline__ int v_rd_base(int lane) { return ((lane & 3) << 3) | (((lane >> 2) & 3) << 6) | (((lane >> 4) & 1) << 5) | (((lane >> 5) & 1) << 8); }
constexpr int v_rd_off(int d0, int ks, int half) { return d0 * 512 + ks * 4096 + half * 2048; }
__device__ __forceinline__ int crow(int r, int hi) { return (r & 3) + 8 * (r >> 2) + 4 * hi; }
__device__ __forceinline__ unsigned cvtpk(float lo, float hi) { unsigned r; asm volatile("v_cvt_pk_bf16_f32 %0, %1, %2" : "=v"(r) : "v"(lo), "v"(hi)); return r; }
__device__ __forceinline__ bf16x8 load8(const bf16* p) { return *reinterpret_cast<const bf16x8*>(p); }
__device__ __forceinline__ void mask_tile(f32x16& p0, f32x16& p1, int dq) {
    const float NEG = -__builtin_inff();
#pragma unroll
    for (int r = 0; r < 16; ++r) { const int c = (r & 3) + 8 * (r >> 2); if (dq - c < 0) p0[r] = NEG; if (dq - c - 32 < 0) p1[r] = NEG; }
}
__device__ __forceinline__ bool softmax_tile(f32x16& p0, f32x16& p1, float& m_reg, float& l_reg, float& alpha, bf16x8& pa0, bf16x8& pa1, bf16x8& pa2, bf16x8& pa3) {
    float pmax = p0[0];
#pragma unroll
    for (int r = 1; r < 16; ++r) pmax = fmaxf(pmax, p0[r]);
#pragma unroll
    for (int r = 0; r < 16; ++r) pmax = fmaxf(pmax, p1[r]);
    { auto rr = __builtin_amdgcn_permlane32_swap(__float_as_uint(pmax), __float_as_uint(pmax), false, false);
      pmax = fmaxf(__uint_as_float(rr[0]), __uint_as_float(rr[1])); }
    bool resc = false; float mn = m_reg; alpha = 1.f;
    if (__builtin_expect(!__all((pmax - m_reg) <= THR2), 0)) { mn = fmaxf(m_reg, pmax); alpha = __builtin_amdgcn_exp2f(m_reg - mn); m_reg = mn; resc = true; }
#pragma unroll
    for (int r = 0; r < 16; ++r) { p0[r] = __builtin_amdgcn_exp2f(p0[r] - mn); p1[r] = __builtin_amdgcn_exp2f(p1[r] - mn); }
    float ps = 0;
#pragma unroll
    for (int r = 0; r < 16; ++r) ps += p0[r];
#pragma unroll
    for (int r = 0; r < 16; ++r) ps += p1[r];
    { auto rr = __builtin_amdgcn_permlane32_swap(__float_as_uint(ps), __float_as_uint(ps), false, false);
      ps = __uint_as_float(rr[0]) + __uint_as_float(rr[1]); }
    l_reg = l_reg * alpha + ps;
#define PK8(P, B_, OUT) do { u32x4 w = {cvtpk(P[B_+0], P[B_+1]), cvtpk(P[B_+2], P[B_+3]), cvtpk(P[B_+4], P[B_+5]), cvtpk(P[B_+6], P[B_+7])}; OUT = *reinterpret_cast<bf16x8*>(&w); } while (0)
    PK8(p0, 0, pa0); PK8(p0, 8, pa1); PK8(p1, 0, pa2); PK8(p1, 8, pa3);
#undef PK8
    return resc;
}
template <bool ROPE, bool ALIBI>
__device__ __forceinline__ void qkt(f32x16& p0, f32x16& p1, const char* kimg, const char* k2img, int r32, int hi, const bf16x8* qr, const char* qr2, const bf16x8& qb, const bf16x8& kb0, const bf16x8& kb1) {
#pragma unroll
    for (int d0 = 0; d0 < 8; ++d0) { const char* a = kimg + KSWZ(r32, (d0 * 16 + hi * 8) * 2);
        bf16x8 b0 = *reinterpret_cast<const bf16x8*>(a);
        bf16x8 b1 = *reinterpret_cast<const bf16x8*>(a + 32 * 256);
        if (d0 == 0) { p0 = __builtin_amdgcn_mfma_f32_32x32x16_bf16(b0, qr[0], f32x16{}, 0, 0, 0); p1 = __builtin_amdgcn_mfma_f32_32x32x16_bf16(b1, qr[0], f32x16{}, 0, 0, 0); }
        else { p0 = __builtin_amdgcn_mfma_f32_32x32x16_bf16(b0, qr[d0], p0, 0, 0, 0); p1 = __builtin_amdgcn_mfma_f32_32x32x16_bf16(b1, qr[d0], p1, 0, 0, 0); } }
    if constexpr (ROPE) {
#pragma unroll
        for (int d0 = 0; d0 < 4; ++d0) { const char* a = k2img + K2SWZ(r32, (d0 * 16 + hi * 8) * 2);
            bf16x8 b0 = *reinterpret_cast<const bf16x8*>(a);
            bf16x8 b1 = *reinterpret_cast<const bf16x8*>(a + 32 * 128);
            const bf16x8 q2 = *reinterpret_cast<const bf16x8*>(qr2 + d0 * 1024);
            p0 = __builtin_amdgcn_mfma_f32_32x32x16_bf16(b0, q2, p0, 0, 0, 0);
            p1 = __builtin_amdgcn_mfma_f32_32x32x16_bf16(b1, q2, p1, 0, 0, 0); }
    }
    if constexpr (ALIBI) { p0 = __builtin_amdgcn_mfma_f32_32x32x16_bf16(kb0, qb, p0, 0, 0, 0); p1 = __builtin_amdgcn_mfma_f32_32x32x16_bf16(kb1, qb, p1, 0, 0, 0); }
}
typedef short v4i16_t __attribute__((ext_vector_type(4)));
typedef __attribute__((address_space(3))) v4i16_t* lds_v4i16_ptr;
__device__ __forceinline__ s16x4 vtr(int addr) { return __builtin_bit_cast(s16x4, __builtin_amdgcn_ds_read_tr16_b64_v4i16((lds_v4i16_ptr)(uintptr_t)(unsigned)addr)); }
__device__ __forceinline__ void pv_tile(f32x16* o, int vb0, bf16x8 pa0, bf16x8 pa1, bf16x8 pa2, bf16x8 pa3) {
#pragma unroll
    for (int d0 = 0; d0 < 4; ++d0) { const int b_ = vb0 + d0 * 512;
        const s16x4 l0 = vtr(b_), h0 = vtr(b_ + 2048), l1 = vtr(b_ + 4096), h1 = vtr(b_ + 6144), l2 = vtr(b_ + 8192), h2 = vtr(b_ + 10240), l3 = vtr(b_ + 12288), h3 = vtr(b_ + 14336);
        o[d0] = __builtin_amdgcn_mfma_f32_32x32x16_bf16((bf16x8){l0[0], l0[1], l0[2], l0[3], h0[0], h0[1], h0[2], h0[3]}, pa0, o[d0], 0, 0, 0);
        o[d0] = __builtin_amdgcn_mfma_f32_32x32x16_bf16((bf16x8){l1[0], l1[1], l1[2], l1[3], h1[0], h1[1], h1[2], h1[3]}, pa1, o[d0], 0, 0, 0);
        o[d0] = __builtin_amdgcn_mfma_f32_32x32x16_bf16((bf16x8){l2[0], l2[1], l2[2], l2[3], h2[0], h2[1], h2[2], h2[3]}, pa2, o[d0], 0, 0, 0);
        o[d0] = __builtin_amdgcn_mfma_f32_32x32x16_bf16((bf16x8){l3[0], l3[1], l3[2], l3[3], h3[0], h3[1], h3[2], h3[3]}, pa3, o[d0], 0, 0, 0); }
}
template <bool ROPE, bool ALIBI>
__device__ __forceinline__ void qkt_pv(f32x16& p0, f32x16& p1, f32x16* o, const char* kimg, const char* k2img, int vb, int r32, int hi, const bf16x8* qr, const char* qr2,
                                       const bf16x8& qb, const bf16x8& kb0, const bf16x8& kb1, const bf16x8& pa0, const bf16x8& pa1, const bf16x8& pa2, const bf16x8& pa3) {
    constexpr int NQP = 8 + (ROPE ? 4 : 0) + (ALIBI ? 1 : 0);
    constexpr int NSTEP = (2 * NQP > 16) ? 2 * NQP : 16, DEPTH = 5;
    bf16x8 A[NSTEP], B2[NSTEP], V[16];
#define QKPV_LOAD(t_) do { if ((t_) < 2 * NQP) { const int pr = (t_) >> 1, wh = (t_) & 1;                                                                         \
            if (pr < 8) A[t_] = *reinterpret_cast<const bf16x8*>(kimg + KSWZ(r32, (pr * 16 + hi * 8) * 2) + wh * (32 * 256));                                         \
            else if (ROPE && pr < 12) { A[t_] = *reinterpret_cast<const bf16x8*>(k2img + K2SWZ(r32, ((pr - 8) * 16 + hi * 8) * 2) + wh * (32 * 128));                  \
                                        if (wh == 0) B2[t_] = *reinterpret_cast<const bf16x8*>(qr2 + (pr - 8) * 1024); } }                                               \
        if ((t_) < 16) { const int ks = (t_) >> 2, d0 = (t_) & 3; const int b_ = vb + d0 * 512 + ks * 4096; const s16x4 l = vtr(b_), h = vtr(b_ + 2048);                \
            V[t_] = (bf16x8){l[0], l[1], l[2], l[3], h[0], h[1], h[2], h[3]}; } } while (0)
#pragma unroll
    for (int t = 0; t < DEPTH; ++t) QKPV_LOAD(t);
#pragma unroll
    for (int t = 0; t < NSTEP; ++t) {
        if (t + DEPTH < NSTEP) QKPV_LOAD(t + DEPTH);
        if (t < 2 * NQP) { const int pr = t >> 1, wh = t & 1; bf16x8 Aop, Bop;
            if (pr < 8) { Aop = A[t]; Bop = qr[pr]; } else if (ROPE && pr < 12) { Aop = A[t]; Bop = B2[t & ~1]; } else { Aop = wh ? kb1 : kb0; Bop = qb; }
            if (wh == 0) p0 = __builtin_amdgcn_mfma_f32_32x32x16_bf16(Aop, Bop, pr == 0 ? f32x16{} : p0, 0, 0, 0);
            else p1 = __builtin_amdgcn_mfma_f32_32x32x16_bf16(Aop, Bop, pr == 0 ? f32x16{} : p1, 0, 0, 0); }
        if (t < 16) { const int ks = t >> 2, d0 = t & 3; const bf16x8 P = (ks == 0) ? pa0 : (ks == 1) ? pa1 : (ks == 2) ? pa2 : pa3;
            o[d0] = __builtin_amdgcn_mfma_f32_32x32x16_bf16(V[t], P, o[d0], 0, 0, 0); }
        SBAR();
    }
#undef QKPV_LOAD
}
struct BlockRef { const bf16* Q; const bf16* K; const bf16* K2; const bf16* V; bf16* O; int P0; float sl2; };
__device__ __forceinline__ void glds16(const void* sbase, unsigned voff, unsigned lds_dst) { unsigned keep;
    asm volatile("s_mov_b32 %0, m0\n\ts_mov_b32 m0, %3\n\ts_nop 0\n\tglobal_load_lds_dwordx4 %2, %1\n\ts_mov_b32 m0, %0" : "=&s"(keep) : "s"(sbase), "v"(voff), "s"(lds_dst) : "memory"); }
template <int QP, int KP, int VP, int OP, bool ROPE, bool ALIBI>
__device__ __forceinline__ void attn_block(const BlockRef& cur, char* lds, const int wid) {
    constexpr int NS = ROPE ? 3 : 4;
    const int lane = lane_fresh(), r32 = lane & 31, hi = lane >> 5;
    const int NT = cur.P0 / KVBLK + QB / KVBLK;
    const bool lead = wid < 4;
    const int qlo = cur.P0 + wid * QBLK, qm = qlo + r32 - 4 * hi;
    float l_reg = 0; f32x16 o[4] = {};
    const unsigned ldsb = (unsigned)(uintptr_t)lds;
    const int vb0 = (int)ldsb + OFF_V + v_rd_base(lane);
    const float sl2 = cur.sl2;
    unsigned koff[2], voff[2], k2off = 0;
#pragma unroll
    for (int i = 0; i < 2; ++i) { const int p = wid * 2 + i;
        { const int row = 4 * p + (lane >> 4), c = (lane & 15) ^ (row & 15); koff[i] = (unsigned)(row * KP + c * 8) * 2u; }
        { const int sidx = 2 * p + (lane >> 5), kk = (sidx >> 2) * 8 + ((lane & 31) >> 2), k = kk  , c = (sidx & 3) * 32 + (lane & 3) * 8;
          voff[i] = (unsigned)(k * VP + c) * 2u; } }
    if constexpr (ROPE) { const int row = 8 * wid + (lane >> 3), c = (lane & 7) ^ ((row >> 1) & 7); k2off = (unsigned)(row * 64 + c * 8) * 2u; }
#define TILE(s_) (NT - 1 - (s_))
#define ISSUE_K(s_, slot) do { const int t_ = TILE(s_); const char* kb_ = (const char*)cur.K + (size_t)t_ * (KVBLK * KP * 2);                                                            \
        glds16(kb_, koff[0], ldsb + OFF_K + (slot) * SHM_K + (wid * 2 + 0) * 1024); glds16(kb_, koff[1], ldsb + OFF_K + (slot) * SHM_K + (wid * 2 + 1) * 1024);                        \
        if constexpr (ROPE) glds16((const char*)cur.K2 + (size_t)t_ * (KVBLK * 64 * 2), k2off, ldsb + OFF_K2 + (slot) * SHM_K2 + wid * 1024); } while (0)
#define ISSUE_V(s_, slot) do { const char* vb_ = (const char*)cur.V + (size_t)TILE(s_) * (KVBLK * VP * 2);                                                                             \
        glds16(vb_, voff[0], ldsb + OFF_V + (slot) * SHM_V + (wid * 2 + 0) * 1024); glds16(vb_, voff[1], ldsb + OFF_V + (slot) * SHM_V + (wid * 2 + 1) * 1024); } while (0)
#define BAR_ALL() asm volatile("s_waitcnt lgkmcnt(0)\n\ts_barrier" ::: "memory")
    f32x16 p0, p1; float alpha = 1.f, m_reg = -1e30f; bool resc = false; bf16x8 pa0, pa1, pa2, pa3; bf16x8 qr[8];
    char* qr2 = lds + OFF_QR + wid * 4096 + lane * 16;
    bf16x8 qb = {}, kb0 = {}, kb1 = {};
    if constexpr (ALIBI) { const unsigned shi = cvtpk(sl2, 0.f) & 0xffffu, slo = cvtpk(sl2 - __uint_as_float(shi << 16), 0.f) & 0xffffu;
        const unsigned s64hi = cvtpk(64.f * __uint_as_float(shi << 16), 0.f) & 0xffffu, s64lo = cvtpk(64.f * __uint_as_float(slo << 16), 0.f) & 0xffffu;
        const unsigned nq = cvtpk(-(float)(wid * QBLK + r32), 0.f) & 0xffffu, k0 = cvtpk((float)r32, 0.f) & 0xffffu, k1 = cvtpk((float)(32 + r32), 0.f) & 0xffffu;
        u32x4 q_ = {nq | (nq << 16), shi | (slo << 16), s64hi | (s64lo << 16), 0u}, a_ = {shi | (slo << 16), k0 | (k0 << 16), 0u, 0u}, b_ = {shi | (slo << 16), k1 | (k1 << 16), 0u, 0u};
        if (hi) { q_ = (u32x4){0u, 0u, 0u, 0u}; }
        qb = *reinterpret_cast<bf16x8*>(&q_); kb0 = *reinterpret_cast<bf16x8*>(&a_); kb1 = *reinterpret_cast<bf16x8*>(&b_); }
#pragma unroll
    for (int d0 = 0; d0 < 8; ++d0) qr[d0] = load8(cur.Q + (size_t)(wid * QBLK + r32) * QP + d0 * 16 + hi * 8);
    if constexpr (ROPE) {
#pragma unroll
        for (int d0 = 0; d0 < 4; ++d0) *(bf16x8*)(qr2 + d0 * 1024) = load8(cur.Q + (size_t)(wid * QBLK + r32) * QP + 128 + d0 * 16 + hi * 8); }
    ISSUE_K(0, 0); ISSUE_V(0, 0); ISSUE_K(1, 1);
    if constexpr (NS == 4) { ISSUE_V(1, 1); ISSUE_K(2, 2); }
    asm volatile("s_waitcnt vmcnt(0) lgkmcnt(0)\n\ts_barrier" ::: "memory");
#pragma unroll
    for (int d0 = 0; d0 < 8; ++d0) asm volatile("" : "+v"(qr[d0]));
    int ks = 0, vs = 0;
    int kis = NS - 1, vis = NS - 2;
    int rq = 0;
#define REQUEST() do { const int sk_ = rq + NS - 1, sv_ = rq + NS - 2; if (sv_ < NT) { if (sk_ < NT) ISSUE_K(sk_, kis); ISSUE_V(sv_, vis); } kis = (kis == NS - 1) ? 0 : kis + 1; vis = (vis == NS - 1) ? 0 : vis + 1; ++rq; } while (0)
#define LANDED() do { if (rq + NS - 2 < NT) { if constexpr (ROPE) asm volatile("s_waitcnt vmcnt(5)" ::: "memory"); else asm volatile("s_waitcnt vmcnt(8)" ::: "memory"); } else asm volatile("s_waitcnt vmcnt(0)" ::: "memory"); } while (0)
#define SET_N(s_) do { if constexpr (ALIBI) { const unsigned nn = cvtpk((float)(TILE(s_) - cur.P0 / KVBLK), 0.f) & 0xffffu; u32x4 a_ = *reinterpret_cast<u32x4*>(&kb0), b_ = *reinterpret_cast<u32x4*>(&kb1); a_[2] = nn | (nn << 16); b_[2] = a_[2]; \
        kb0 = *reinterpret_cast<bf16x8*>(&a_); kb1 = *reinterpret_cast<bf16x8*>(&b_); } } while (0)
#define QKT(s_) do { SET_N(s_); qkt<ROPE, ALIBI>(p0, p1, lds + OFF_K + ks * SHM_K, lds + OFF_K2 + ks * SHM_K2, r32, hi, qr, qr2, qb, kb0, kb1); ks = (ks == NS - 1) ? 0 : ks + 1; } while (0)
#define PV() do { pv_tile(o, vb0 + vs * SHM_V, pa0, pa1, pa2, pa3); vs = (vs == NS - 1) ? 0 : vs + 1; } while (0)
#define RESCALE() do { if (resc) { _Pragma("unroll") for (int d_ = 0; d_ < 4; ++d_) _Pragma("unroll") for (int r = 0; r < 16; ++r) o[d_][r] *= alpha; } } while (0)
#define SOFTMAX(s_, MASKED) do { if (MASKED) { const int kb_ = TILE(s_) * KVBLK; if (kb_ + KVBLK - 1 > qlo) mask_tile(p0, p1, qm - kb_); } resc = softmax_tile(p0, p1, m_reg, l_reg, alpha, pa0, pa1, pa2, pa3); } while (0)
    if (false) __builtin_amdgcn_s_setprio(1);
    if (!lead) REQUEST();
    if (lead) { QKT(0); }
    BAR_ALL();
    if (lead) { REQUEST(); SOFTMAX(0, true); } else { QKT(0); }
    LANDED(); BAR_ALL();
    if (!lead) { REQUEST(); SOFTMAX(0, true); BAR_ALL(); }
    for (int s_ = 1; s_ < NT; ++s_) {
        RESCALE();
        __builtin_amdgcn_s_setprio(1);
        SET_N(s_); qkt_pv<ROPE, ALIBI>(p0, p1, o, lds + OFF_K + ks * SHM_K, lds + OFF_K2 + ks * SHM_K2, vb0 + vs * SHM_V, r32, hi, qr, qr2, qb, kb0, kb1, pa0, pa1, pa2, pa3);
        ks = (ks == NS - 1) ? 0 : ks + 1; vs = (vs == NS - 1) ? 0 : vs + 1;
        __builtin_amdgcn_s_setprio(0);
        if (!lead) LANDED();
        BAR_ALL();
        REQUEST();
        if (s_ < 4) SOFTMAX(s_, true); else SOFTMAX(s_, false);
        if (lead) LANDED();
        BAR_ALL();
    }
    RESCALE();
    PV();
    BAR_ALL();
    if (lead) BAR_ALL();
    __builtin_amdgcn_s_setprio(0);
#undef REQUEST
#undef LANDED
#undef SET_N
#undef QKT
#undef PV
#undef RESCALE
#undef SOFTMAX
    { const float rl = __builtin_amdgcn_rcpf(l_reg);
      int lane_e = lane; asm volatile("" : "+v"(lane_e));
      bf16* Ow = cur.O + (size_t)(wid * QBLK + (lane_e & 31)) * OP + 4 * (lane_e >> 5);
#pragma unroll
      for (int d0 = 0; d0 < 4; ++d0)
#pragma unroll
          for (int g = 0; g < 4; ++g) { uint2 w; w.x = cvtpk(o[d0][4 * g] * rl, o[d0][4 * g + 1] * rl); w.y = cvtpk(o[d0][4 * g + 2] * rl, o[d0][4 * g + 3] * rl);
              *(uint2*)(Ow + d0 * 32 + 8 * g) = w; } }
    asm volatile("s_waitcnt vmcnt(0) lgkmcnt(0)\n\ts_barrier" ::: "memory");
#undef TILE
#undef ISSUE_K
#undef ISSUE_V
#undef BAR_ALL
}
#undef OFF_K
#undef OFF_V
#undef OFF_K2
#undef OFF_QR
}

#define GAS __attribute__((address_space(1)))
#define LAS __attribute__((address_space(3)))
typedef unsigned short bf16;
typedef unsigned v4u __attribute__((ext_vector_type(4)));
typedef float f32x4 __attribute__((ext_vector_type(4)));
typedef short bf16x8 __attribute__((ext_vector_type(8)));
typedef GAS unsigned gu32;
typedef GAS unsigned long long gu64;
#define RLX_AGENT __ATOMIC_RELAXED, __HIP_MEMORY_SCOPE_AGENT
#define LDS_WAIT() asm volatile("s_waitcnt lgkmcnt(0)" ::: "memory")
#define VM_WAIT() asm volatile("s_waitcnt vmcnt(0)" ::: "memory")
__device__ __forceinline__ unsigned long long rt() { return __builtin_amdgcn_s_memrealtime(); }
__device__ __forceinline__ unsigned f2bf(float f) { unsigned u = __builtin_bit_cast(unsigned, f); return (u + 0x7fffu + ((u >> 16) & 1u)) >> 16; }
__device__ __forceinline__ unsigned pk2(float lo, float hi) { return f2bf(lo) | (f2bf(hi) << 16); }

#define XB_TMO      128
#define XB_XCNT(j)  (256  + 64 * (j))
#define XB_XSUB(j)  (1280 + 64 * (j))
#define XB_XGEN(j)  (2304 + 64 * (j))
#define XB_TOP      3328
#define XB_TOPGEN   3392
#define XCD_BAR_WORDS 3456
#define XB_SPIN_CAP (1u << 18)

__device__ __forceinline__ unsigned xb_ld(unsigned* p)              { return __hip_atomic_load(p, __ATOMIC_RELAXED, __HIP_MEMORY_SCOPE_AGENT); }
__device__ __forceinline__ unsigned xb_add(unsigned* p, unsigned v) { return __hip_atomic_fetch_add(p, v, __ATOMIC_RELAXED, __HIP_MEMORY_SCOPE_AGENT); }
__device__ __forceinline__ unsigned xb_xcc_id() { return (unsigned)__builtin_amdgcn_s_getreg((3 << 11) | 20) & 0xFu; }
#define XB_SPIN(cond, bar) do { unsigned _sp = 0; while (cond) { __builtin_amdgcn_s_sleep(1); \
    if ((++_sp & 255u) == 0u) { if (xb_ld(&(bar)[XB_TMO])) break; if (_sp > XB_SPIN_CAP) { atomicAdd(&(bar)[XB_TMO], 1u); break; } } } } while (0)

struct XcdBarrier {
    unsigned* bar; unsigned x;
    volatile LAS unsigned* st;
};

__device__ __forceinline__ XcdBarrier xcd_barrier_post(unsigned* bar, volatile LAS unsigned* st) {
    XcdBarrier b; b.bar = bar; b.x = xb_xcc_id(); b.st = st;
    if (threadIdx.x == 0) (void)xb_add(&bar[XB_XCNT(b.x)], 1u);
    return b;
}
__device__ __forceinline__ void xcd_barrier_complete(unsigned* bar, unsigned x, unsigned& nloc, unsigned& nx) {
    const unsigned G = gridDim.x * gridDim.y * gridDim.z;
    unsigned sum, cnt, mine, sp = 0u;
    for (;;) {
        sum = 0u; cnt = 0u; mine = 0u;
#pragma unroll
        for (unsigned j = 0; j < 16; ++j) { const unsigned c = xb_ld(&bar[XB_XCNT(j)]); sum += c; cnt += (c > 0u) ? 1u : 0u; mine = (j == x) ? c : mine; }
        if (sum == G) break;
        __builtin_amdgcn_s_sleep(1);
        if ((++sp & 255u) == 0u) { if (xb_ld(&bar[XB_TMO])) break; if (sp > XB_SPIN_CAP) { atomicAdd(&bar[XB_TMO], 1u); break; } }
    }
    nloc = mine > 0u ? mine : 1u; nx = cnt > 0u ? cnt : 1u;
}

__device__ __forceinline__ void xcd_barrier(const XcdBarrier& b, const bool leader  ) {
    asm volatile("s_waitcnt vmcnt(0)" ::: "memory");
    __syncthreads();
    if (leader) {
        unsigned* bar = b.bar;
        __builtin_amdgcn_s_waitcnt(0);
        unsigned nloc = b.st[0], nx = b.st[1];
        if (nloc == 0u) { xcd_barrier_complete(bar, b.x, nloc, nx); b.st[0] = nloc; b.st[1] = nx; }
        const unsigned old = xb_add(&bar[XB_XSUB(b.x)], 1u);
        const unsigned gen = old / nloc;
        if (old + 1u == (gen + 1u) * nloc) {
            __builtin_amdgcn_fence(__ATOMIC_RELEASE, "agent");
            asm volatile("s_waitcnt vmcnt(0)" ::: "memory");
            const unsigned og = xb_add(&bar[XB_TOP], 1u);
            const unsigned tg = og / nx;
            if (og + 1u == (tg + 1u) * nx) xb_add(&bar[XB_TOPGEN], 1u);
            else XB_SPIN(xb_ld(&bar[XB_TOPGEN]) == tg, bar);
            __builtin_amdgcn_fence(__ATOMIC_ACQUIRE, "agent");
            xb_add(&bar[XB_XGEN(b.x)], 1u);
            asm volatile("s_waitcnt vmcnt(0)" ::: "memory");
        } else {
            XB_SPIN(xb_ld(&bar[XB_XGEN(b.x)]) == gen, bar);
            __builtin_amdgcn_fence(__ATOMIC_ACQUIRE, "agent");
            asm volatile("s_waitcnt vmcnt(0)" ::: "memory");
        }
    }
    __syncthreads();
}

constexpr int NWAVES = 8;
constexpr size_t MiB = 1u << 20;
constexpr size_t WS_CTL = 0, CTL_ZERO_BYTES = 1 * MiB;
constexpr size_t WS_ROPE = 1 * MiB;
constexpr size_t WS_WIN = 2 * MiB, WS_WUQ = 18 * MiB, WS_WUKV = 20 * MiB, WS_WR0 = 21 * MiB, WS_WR1 = 21 * MiB + 512 * 1024, WS_WO0 = 22 * MiB, WS_WQKV = 30 * MiB, WS_WO1 = 54 * MiB;
constexpr size_t WS_WUP0 = 64 * MiB, WS_WDN0 = 192 * MiB, WS_WUP1 = 256 * MiB, WS_WDN1 = 384 * MiB;
constexpr size_t WS_XR = 448 * MiB, WS_HN = 576 * MiB;
constexpr size_t WS_ZIN = 640 * MiB, WS_Q = 640 * MiB, WS_KNV = 688 * MiB, WS_CAT = 832 * MiB, WS_QL = 896 * MiB, WS_KVL = 912 * MiB, WS_KR = 920 * MiB;
constexpr size_t WS_Q1 = 640 * MiB, WS_K1 = 704 * MiB, WS_V1 = 768 * MiB, WS_ATT = 832 * MiB, WS_OD = 896 * MiB;
constexpr size_t WS_AP = 640 * MiB, WS_HS = 800 * MiB, WS_Y = 840 * MiB, WS_MOE = 1000 * MiB, WS_END = 1024 * MiB;
constexpr int NCHUNK = NTOK / 64;
constexpr int MAXTILE = 160;
constexpr int MO_EID = 0, MO_EW = 2 * NTOK  , MO_LRANK = 4 * NTOK, MO_TOKSLOT = 6 * NTOK, MO_HIST = 8 * NTOK  , MO_TILEE = MO_HIST + NCHUNK * 32  , MO_NTILE = MO_TILEE + 256, MO_RSTD = MO_NTILE + 64  ;
constexpr int CW_BAR = 4096;
constexpr int RING_OFF = 0, RING_BYTES = 155648;
constexpr int LDSCTL_OFF = RING_BYTES, MISC_OFF = LDSCTL_OFF + 320;
constexpr int LDS_BYTES = 156672;
static_assert(MISC_OFF + 128 <= LDS_BYTES && att::LDS_BYTES <= RING_BYTES && pg8::STAGE_BYTES <= RING_BYTES, "LDS map");

struct Frame {
    LAS unsigned char* lds; volatile LAS unsigned* MISC; gu32* ctl; unsigned char* ws;
    int wave, vcu, G;
};
__device__ __forceinline__ float wave_sum(float v) {
#pragma unroll
    for (int o = 1; o < 64; o <<= 1) v += __shfl_xor(v, o);
    return v;
}
__device__ __forceinline__ unsigned cvtpk(float lo, float hi) { unsigned r; asm volatile("v_cvt_pk_bf16_f32 %0, %1, %2" : "=v"(r) : "v"(lo), "v"(hi)); return r; }
__device__ __forceinline__ float bf_lo(unsigned w) { return __uint_as_float(w << 16); }
__device__ __forceinline__ float bf_hi(unsigned w) { return __uint_as_float(w & 0xffff0000u); }
typedef unsigned v2u __attribute__((ext_vector_type(2)));

template <class RowMap>
__device__ __forceinline__ void tr_item(const float* W, int K, int N, bf16* WT, LAS float* scr, int item, int lane, RowMap rm) {
    const int nblk = N / 64, kb = item / nblk, nb = item - kb * nblk, k0 = 64 * kb, n0 = 64 * nb;
    const float* src = W + (size_t)(k0 + (lane >> 4)) * N + n0 + (lane & 15) * 4;
    f32x4 v[16];
#pragma unroll
    for (int i = 0; i < 16; ++i) v[i] = *(const f32x4*)(src + (size_t)(4 * i) * N);
#pragma unroll
    for (int i = 0; i < 16; ++i) { LAS float* d = scr + (4 * i + (lane >> 4)) * 65 + (lane & 15) * 4; d[0] = v[i][0]; d[1] = v[i][1]; d[2] = v[i][2]; d[3] = v[i][3]; }
    LDS_WAIT(); asm volatile("" ::: "memory");
    const int c = lane & 7;
#pragma unroll
    for (int j = 0; j < 8; ++j) { const int n = (lane >> 3) + 8 * j; const LAS float* s = scr + (8 * c) * 65 + n;
        v4u o; o.x = cvtpk(s[0 * 65], s[1 * 65]); o.y = cvtpk(s[2 * 65], s[3 * 65]); o.z = cvtpk(s[4 * 65], s[5 * 65]); o.w = cvtpk(s[6 * 65], s[7 * 65]);
        *(GAS v4u*)(WT + (size_t)rm(n0 + n) * K + k0 + 8 * c) = o; }
    LDS_WAIT(); asm volatile("" ::: "memory");
}
struct TrDesc { const float* src; bf16* dst; int N, K, k0, n0, type; };
__device__ __forceinline__ int tr_dst_row(int type, int n) {
    if (type == 1) { const int h = n / 192, d = n - h * 192; if (d < 128) return n; const int i = d - 128; return h * 192 + 128 + ((i < 32) ? 2 * i : 2 * (i - 32) + 1); }
    if (type == 2) { const int h = n >> 8, c = n & 255; return (c < 128) ? h * 128 + c : 1024 + h * 128 + (c - 128); }
    if (type == 3) { const int bj = n >> 9, r = n & 511; return (r >> 7) * 256 + bj * 128 + (r & 127); }
    return n;
}
__device__ __forceinline__ void tr_load(const TrDesc& d, f32x4 (&v)[16], int lane) {
    const float* src = d.src + (size_t)(lane >> 4) * d.N + (lane & 15) * 4;
#pragma unroll
    for (int i = 0; i < 16; ++i) v[i] = *(const GAS f32x4*)(src + (size_t)(4 * i) * d.N);
}
__device__ __forceinline__ void tr_store(const TrDesc& d, const f32x4 (&v)[16], LAS float* scr, int lane) {
#pragma unroll
    for (int i = 0; i < 16; ++i) { LAS float* p = scr + (4 * i + (lane >> 4)) * 65 + (lane & 15) * 4; p[0] = v[i][0]; p[1] = v[i][1]; p[2] = v[i][2]; p[3] = v[i][3]; }
    LDS_WAIT(); asm volatile("" ::: "memory");
    const int c = lane & 7;
#pragma unroll
    for (int j = 0; j < 8; ++j) { const int n = (lane >> 3) + 8 * j; const LAS float* q = scr + (8 * c) * 65 + n;
        v4u o; o.x = cvtpk(q[0 * 65], q[1 * 65]); o.y = cvtpk(q[2 * 65], q[3 * 65]); o.z = cvtpk(q[4 * 65], q[5 * 65]); o.w = cvtpk(q[6 * 65], q[7 * 65]);
        *(GAS v4u*)(d.dst + (size_t)tr_dst_row(d.type, d.n0 + n) * d.K + d.k0 + 8 * c) = o; }
    LDS_WAIT(); asm volatile("" ::: "memory");
}
struct RmId { __device__ __forceinline__ int operator()(int n) const { return n; } };
struct RmUq { __device__ __forceinline__ int operator()(int n) const { const int h = n / 192, d = n - h * 192; if (d < 128) return n; const int i = d - 128; return h * 192 + 128 + ((i < 32) ? 2 * i : 2 * (i - 32) + 1); } };
struct RmUkv { __device__ __forceinline__ int operator()(int n) const { const int h = n >> 8, c = n & 255; return (c < 128) ? h * 128 + c : 1024 + h * 128 + (c - 128); } };
struct RmUp { __device__ __forceinline__ int operator()(int n) const { const int bj = n >> 9, r = n & 511; return (r >> 7) * 256 + bj * 128 + (r & 127); } };
__device__ __forceinline__ void norm_row_to_bf16(const float* xrow, const float* g, bf16* orow, int lane) {
    const GAS f32x4* xr = (const GAS f32x4*)xrow + lane; const GAS f32x4* gr = (const GAS f32x4*)g + lane;
    f32x4 v[8]; float s = 0.f;
#pragma unroll
    for (int j = 0; j < 8; ++j) { v[j] = xr[64 * j]; s += (v[j].x * v[j].x + v[j].y * v[j].y) + (v[j].z * v[j].z + v[j].w * v[j].w); }
    const float rstd = rsqrtf(wave_sum(s) * (1.f / DM) + EPS);
    GAS v2u* o8 = (GAS v2u*)orow + lane;
#pragma unroll
    for (int j = 0; j < 8; ++j) { const f32x4 gg = gr[64 * j]; v2u w; w.x = cvtpk(v[j].x * rstd * gg.x, v[j].y * rstd * gg.y); w.y = cvtpk(v[j].z * rstd * gg.z, v[j].w * rstd * gg.w); o8[64 * j] = w; }
}
struct In { const float* p[32]; };
__device__ __forceinline__ void p0_prologue(Frame& F, const In& in) {
    const int f_lane = lane_fresh(), f_tid = F.wave * 64 + f_lane;
    LAS float* scr = (LAS float*)(F.lds + RING_OFF) + F.wave * (64 * 65);
    const int gw = F.vcu * NWAVES + F.wave, NGW = F.G * NWAVES;
    unsigned char* ws = F.ws;
    constexpr int I_IN = (DM / 64) * (EVEN_IN / 64), I_UQ = (QRANK / 64) * (1536 / 64), I_UKV = (KVRANK / 64) * (2048 / 64), I_O = (DM / 64) * (DM / 64), I_QKV = (DM / 64) * (6144 / 64);
    constexpr int I_UP = (DM / 64) * (1024 / 64), I_DN = (EFF / 64) * (DM / 64);
    constexpr int N_DENSE = I_IN + I_UQ + I_UKV + 2 * I_O + I_QKV, N_MOE = NEXP * (I_UP + I_DN), NITEMS = N_DENSE + 2 * N_MOE;
    auto decode = [&](int it) -> TrDesc {
        TrDesc d; int r = it; const float* W; bf16* WT; int K, N, type = 0;
        if (r < I_IN) { W = in.p[2]; K = DM; N = EVEN_IN; WT = (bf16*)(ws + WS_WIN); }
        else if ((r -= I_IN) < I_UQ) { W = in.p[5]; K = QRANK; N = 1536; WT = (bf16*)(ws + WS_WUQ); type = 1; }
        else if ((r -= I_UQ) < I_UKV) { W = in.p[7]; K = KVRANK; N = 2048; WT = (bf16*)(ws + WS_WUKV); type = 2; }
        else if ((r -= I_UKV) < I_O) { W = in.p[8]; K = DM; N = DM; WT = (bf16*)(ws + WS_WO0); }
        else if ((r -= I_O) < I_QKV) { W = in.p[17]; K = DM; N = 6144; WT = (bf16*)(ws + WS_WQKV); }
        else if ((r -= I_QKV) < I_O) { W = in.p[23]; K = DM; N = DM; WT = (bf16*)(ws + WS_WO1); }
        else { r -= I_O; const int layer = r / N_MOE; r -= layer * N_MOE;
            if (r < NEXP * I_UP) { const int e = r / I_UP; r -= e * I_UP; W = in.p[layer ? 29 : 14] + (size_t)e * DM * 1024; K = DM; N = 1024; WT = (bf16*)(ws + (layer ? WS_WUP1 : WS_WUP0)) + (size_t)e * 1024 * DM; type = 3; }
            else { r -= NEXP * I_UP; const int e = r / I_DN; r -= e * I_DN; W = in.p[layer ? 30 : 15] + (size_t)e * EFF * DM; K = EFF; N = DM; WT = (bf16*)(ws + (layer ? WS_WDN1 : WS_WDN0)) + (size_t)e * DM * EFF; } }
        const int nblk = N / 64, kb = r / nblk, nb = r - kb * nblk;
        d.k0 = 64 * kb; d.n0 = 64 * nb; d.src = W + (size_t)d.k0 * N + d.n0; d.dst = WT; d.N = N; d.K = K; d.type = type; return d; };
    { f32x4 va[16], vb[16]; int it = gw;
      if (it < NITEMS) { TrDesc da = decode(it); tr_load(da, va, f_lane);
          for (;;) {
              const int it1 = it + NGW; TrDesc db = da; if (it1 < NITEMS) { db = decode(it1); tr_load(db, vb, f_lane); }
              tr_store(da, va, scr, f_lane);
              if (it1 >= NITEMS) break;
              const int it2 = it1 + NGW; if (it2 < NITEMS) { da = decode(it2); tr_load(da, va, f_lane); }
              tr_store(db, vb, scr, f_lane);
              if (it2 >= NITEMS) break;
              it = it2; } } }
    { GAS v4u* z = (GAS v4u*)(ws + WS_WIN + (size_t)EVEN_IN * DM * 2); const int nz = (4096 - EVEN_IN) * DM * 2 / 16;
      for (int i = blockIdx.x * 512 + f_tid; i < nz; i += F.G * 512) z[i] = (v4u){0u, 0u, 0u, 0u}; }
    { float* tab = (float*)(ws + WS_ROPE);
      for (int i = blockIdx.x * 512 + f_tid; i < SEQ * 32; i += F.G * 512) { const int t = i >> 5, k = i & 31; const float inv = powf(10000.0f, -(float)(2 * k) / 64.0f), ang = (float)t * inv; tab[2 * i] = cosf(ang); tab[2 * i + 1] = sinf(ang); } }
    for (int layer = 0; layer < 2; ++layer) {
        const float* g = in.p[layer ? 24 : 9]; const float* wg = in.p[layer ? 25 : 10]; const float* we = in.p[layer ? 27 : 12];
        GAS v4u* dst = (GAS v4u*)(ws + (layer ? WS_WR1 : WS_WR0));
        for (int i = blockIdx.x * 512 + f_tid; i < 64 * 3 * 64; i += F.G * 512) {
            const int ln = i & 63, nt = (i >> 6) % 3, ks = (i >> 6) / 3, o = 16 * nt + (ln & 15), kb = 32 * ks + 8 * (ln >> 4);
            float hi[8], lo[8];
#pragma unroll
            for (int j = 0; j < 8; ++j) { const int k = kb + j; float w = 0.f; if (o < 4) w = wg[k * 4 + o]; else if (o < 36) w = we[k * 32 + (o - 4)]; w *= g[k];
                const float h = __uint_as_float(cvtpk(w, 0.f) << 16); hi[j] = h; lo[j] = w - h; }
            v4u a, b; a.x = cvtpk(hi[0], hi[1]); a.y = cvtpk(hi[2], hi[3]); a.z = cvtpk(hi[4], hi[5]); a.w = cvtpk(hi[6], hi[7]);
            b.x = cvtpk(lo[0], lo[1]); b.y = cvtpk(lo[2], lo[3]); b.z = cvtpk(lo[4], lo[5]); b.w = cvtpk(lo[6], lo[7]);
            dst[(size_t)((ks * 3 + nt) * 2 + 0) * 64 + ln] = a; dst[(size_t)((ks * 3 + nt) * 2 + 1) * 64 + ln] = b; }
    }
    for (int m = gw; m < NTOK; m += NGW) norm_row_to_bf16(in.p[0] + (size_t)m * DM, in.p[1], (bf16*)(ws + WS_HN) + (size_t)m * DM, f_lane);
}

__device__ __forceinline__ void p2_even_local(Frame& F, const In& in) {
    const int f_lane = lane_fresh(), f_tid = F.wave * 64 + f_lane;
    const int gw = F.vcu * NWAVES + F.wave, NGW = F.G * NWAVES, lane = f_lane;
    const bf16* zin = (const bf16*)(F.ws + WS_ZIN); bf16* cat = (bf16*)(F.ws + WS_CAT); bf16* ql = (bf16*)(F.ws + WS_QL); bf16* kvl = (bf16*)(F.ws + WS_KVL); bf16* kr = (bf16*)(F.ws + WS_KR);
    const float* conv_w = in.p[3]; const float* g_q = in.p[4]; const float* g_kv = in.p[6]; const float* tab = (const float*)(F.ws + WS_ROPE);
    for (int n = gw; n < NTOK; n += NGW) {
        const int tpos = n & (SEQ - 1); const bf16* z = zin + (size_t)n * 4096;
#pragma unroll
        for (int i = 0; i < 2; ++i) { const int c = 8 * lane + 512 * i; float acc[8] = {0.f, 0.f, 0.f, 0.f, 0.f, 0.f, 0.f, 0.f};
#pragma unroll
            for (int j = 0; j < 3; ++j) { if (tpos - 2 + j >= 0) { const bf16* zz = z - (size_t)(2 - j) * 4096;
                    const v4u gc = *(const GAS v4u*)(zz + CONVW + c), uu = *(const GAS v4u*)(zz + 2 * CONVW + c);
                    const f32x4 w0 = *(const GAS f32x4*)(conv_w + j * CONVW + c), w1 = *(const GAS f32x4*)(conv_w + j * CONVW + c + 4);
                    acc[0] += w0.x * bf_lo(gc.x) * bf_lo(uu.x); acc[1] += w0.y * bf_hi(gc.x) * bf_hi(uu.x); acc[2] += w0.z * bf_lo(gc.y) * bf_lo(uu.y); acc[3] += w0.w * bf_hi(gc.y) * bf_hi(uu.y);
                    acc[4] += w1.x * bf_lo(gc.z) * bf_lo(uu.z); acc[5] += w1.y * bf_hi(gc.z) * bf_hi(uu.z); acc[6] += w1.z * bf_lo(gc.w) * bf_lo(uu.w); acc[7] += w1.w * bf_hi(gc.w) * bf_hi(uu.w); } }
            const v4u gb = *(const GAS v4u*)(z + c); v4u o;
            o.x = cvtpk(bf_lo(gb.x) * acc[0], bf_hi(gb.x) * acc[1]); o.y = cvtpk(bf_lo(gb.y) * acc[2], bf_hi(gb.y) * acc[3]); o.z = cvtpk(bf_lo(gb.z) * acc[4], bf_hi(gb.z) * acc[5]); o.w = cvtpk(bf_lo(gb.w) * acc[6], bf_hi(gb.w) * acc[7]);
            *(GAS v4u*)(cat + (size_t)n * DM + c) = o; }
        { const v4u q = *(const GAS v4u*)(z + 3 * CONVW + 8 * lane); float v[8] = {bf_lo(q.x), bf_hi(q.x), bf_lo(q.y), bf_hi(q.y), bf_lo(q.z), bf_hi(q.z), bf_lo(q.w), bf_hi(q.w)}; float s = 0.f;
#pragma unroll
          for (int j = 0; j < 8; ++j) s += v[j] * v[j];
          const float r = rsqrtf(wave_sum(s) * (1.f / QRANK) + EPS); const f32x4 g0 = *(const GAS f32x4*)(g_q + 8 * lane), g1 = *(const GAS f32x4*)(g_q + 8 * lane + 4);
          v4u o; o.x = cvtpk(v[0] * r * g0.x, v[1] * r * g0.y); o.y = cvtpk(v[2] * r * g0.z, v[3] * r * g0.w); o.z = cvtpk(v[4] * r * g1.x, v[5] * r * g1.y); o.w = cvtpk(v[6] * r * g1.z, v[7] * r * g1.w);
          *(GAS v4u*)(ql + (size_t)n * QRANK + 8 * lane) = o; }
        { const v2u q = *(const GAS v2u*)(z + 3 * CONVW + QRANK + 4 * lane); float v[4] = {bf_lo(q.x), bf_hi(q.x), bf_lo(q.y), bf_hi(q.y)};
          const float s = (v[0] * v[0] + v[1] * v[1]) + (v[2] * v[2] + v[3] * v[3]);
          const float r = rsqrtf(wave_sum(s) * (1.f / KVRANK) + EPS); const f32x4 g0 = *(const GAS f32x4*)(g_kv + 4 * lane);
          v2u o; o.x = cvtpk(v[0] * r * g0.x, v[1] * r * g0.y); o.y = cvtpk(v[2] * r * g0.z, v[3] * r * g0.w);
          *(GAS v2u*)(kvl + (size_t)n * KVRANK + 4 * lane) = o; }
        if (lane < 32) { const float t1 = __uint_as_float((unsigned)z[3 * CONVW + QRANK + KVRANK + lane] << 16), t2 = __uint_as_float((unsigned)z[3 * CONVW + QRANK + KVRANK + 32 + lane] << 16);
          const float c = tab[((size_t)tpos * 32 + lane) * 2], s = tab[((size_t)tpos * 32 + lane) * 2 + 1];
          *(GAS unsigned*)(kr + (size_t)n * 64 + 2 * lane) = cvtpk(t1 * c - t2 * s, t1 * s + t2 * c); }
    }
}

__device__ __forceinline__ void p6_route(Frame& F, const float* g, const float* bg, const float* be, const unsigned char* wfrag) {
    const int f_lane = lane_fresh(), f_tid = F.wave * 64 + f_lane;
    LAS float* LG = (LAS float*)(F.lds + RING_OFF);
    LAS float* SS = LG + 2 * 64 * 48;
    LAS float* RS = SS + 128;
    LAS int* HI = (LAS int*)(RS + 64);
    const int lane = f_lane, w = F.wave, tq = w & 3, kh = w >> 2;
    const bf16* XR = (const bf16*)(F.ws + WS_XR); bf16* HN = (bf16*)(F.ws + WS_HN);
    int* mo = (int*)(F.ws + WS_MOE);
    for (int chunk = F.vcu; chunk < NCHUNK; chunk += F.G) {
        const int n0 = chunk * 64;
        if (f_tid < 32) HI[f_tid] = 0;
        { pg8::f32x4 acc[3] = {{0.f, 0.f, 0.f, 0.f}, {0.f, 0.f, 0.f, 0.f}, {0.f, 0.f, 0.f, 0.f}}; float ss = 0.f;
          const bf16* xp = XR + (size_t)(n0 + 16 * tq + (lane & 15)) * DM + kh * 1024 + 8 * (lane >> 4);
          const GAS v4u* wf = (const GAS v4u*)wfrag + (size_t)(kh * 32) * 6 * 64 + lane;
#pragma unroll 4
          for (int ks = 0; ks < 32; ++ks) {
              const v4u h = *(const GAS v4u*)(xp + 32 * ks);
              { const float a0 = bf_lo(h.x), a1 = bf_hi(h.x), a2 = bf_lo(h.y), a3 = bf_hi(h.y), a4 = bf_lo(h.z), a5 = bf_hi(h.z), a6 = bf_lo(h.w), a7 = bf_hi(h.w);
                ss += (a0 * a0 + a1 * a1) + (a2 * a2 + a3 * a3) + (a4 * a4 + a5 * a5) + (a6 * a6 + a7 * a7); }
              const bf16x8 ah = __builtin_bit_cast(bf16x8, h);
#pragma unroll
              for (int nt = 0; nt < 3; ++nt) { const bf16x8 bh = __builtin_bit_cast(bf16x8, wf[(size_t)((ks * 3 + nt) * 2 + 0) * 64]), bl = __builtin_bit_cast(bf16x8, wf[(size_t)((ks * 3 + nt) * 2 + 1) * 64]);
                  acc[nt] = __builtin_amdgcn_mfma_f32_16x16x32_bf16(ah, bh, acc[nt], 0, 0, 0); acc[nt] = __builtin_amdgcn_mfma_f32_16x16x32_bf16(ah, bl, acc[nt], 0, 0, 0); } }
          ss += __shfl_xor(ss, 16); ss += __shfl_xor(ss, 32);
          if (lane < 16) SS[kh * 64 + 16 * tq + lane] = ss;
#pragma unroll
          for (int nt = 0; nt < 3; ++nt)
#pragma unroll
              for (int r = 0; r < 4; ++r) LG[(kh * 64 + 16 * tq + 4 * (lane >> 4) + r) * 48 + 16 * nt + (lane & 15)] = acc[nt][r]; }
        __syncthreads();
        if (f_tid < 64) {
            const int t = f_tid, n = n0 + t; const float rstd = rsqrtf((SS[t] + SS[64 + t]) * (1.f / DM) + EPS); ((float*)mo)[MO_RSTD + n] = rstd;
            float gl[4];
#pragma unroll
            for (int i = 0; i < 4; ++i) gl[i] = (LG[t * 48 + i] + LG[(64 + t) * 48 + i]) * rstd + bg[i];
            int gi = 0; float gm = gl[0];
#pragma unroll
            for (int i = 1; i < 4; ++i) if (gl[i] > gm) { gm = gl[i]; gi = i; }
            float den = 0.f;
#pragma unroll
            for (int i = 0; i < 4; ++i) den += expf(gl[i] - gm);
            const float gp = 1.f / den;
            float el[8];
#pragma unroll
            for (int i = 0; i < 8; ++i) el[i] = (LG[t * 48 + 4 + gi * 8 + i] + LG[(64 + t) * 48 + 4 + gi * 8 + i]) * rstd + be[gi * 8 + i];
            int i1 = 0; float m1 = el[0];
#pragma unroll
            for (int i = 1; i < 8; ++i) if (el[i] > m1) { m1 = el[i]; i1 = i; }
            int i2 = -1; float m2 = -INFINITY;
#pragma unroll
            for (int i = 0; i < 8; ++i) if (i != i1 && (i2 < 0 || el[i] > m2)) { m2 = el[i]; i2 = i; }
            const float w1 = 1.f / (1.f + expf(m2 - m1)), w2 = 1.f - w1; const int e1 = gi * 8 + i1, e2 = gi * 8 + i2;
            mo[MO_EID + 2 * n] = e1; mo[MO_EID + 2 * n + 1] = e2; ((float*)mo)[MO_EW + 2 * n] = gp * w1; ((float*)mo)[MO_EW + 2 * n + 1] = gp * w2;
            mo[MO_LRANK + 2 * n] = atomicAdd((int*)&HI[e1], 1); mo[MO_LRANK + 2 * n + 1] = atomicAdd((int*)&HI[e2], 1);
        }
        __syncthreads();
        if (f_tid < 32) mo[MO_HIST + chunk * 32 + f_tid] = HI[f_tid];
        __syncthreads();
    }
}

__device__ __forceinline__ void p7_dispatch(Frame& F, const float* g) {
    const int f_lane = lane_fresh(), f_tid = F.wave * 64 + f_lane;
    LAS int* PS = (LAS int*)(F.lds + RING_OFF);
    LAS int* OFF = PS + 1024;
    LAS int* BASE = OFF + 64;
    int* mo = (int*)(F.ws + WS_MOE); const int* hist = mo + MO_HIST;
    const bf16* XR = (const bf16*)(F.ws + WS_XR); bf16* AP = (bf16*)(F.ws + WS_AP);
    for (int chunk = F.vcu; chunk < NCHUNK; chunk += F.G) {
        { const int e = f_tid & 31, part = f_tid >> 5; int sa = 0, sb = 0;
          for (int c = part * (NCHUNK / 16); c < (part + 1) * (NCHUNK / 16); ++c) { const int h = hist[c * 32 + e]; sa += h; if (c < chunk) sb += h; }
          PS[part * 32 + e] = sa; PS[512 + part * 32 + e] = sb; }
        __syncthreads();
        if (f_tid < 32) { int tot = 0, bef = 0;
#pragma unroll
            for (int p = 0; p < 16; ++p) { tot += PS[p * 32 + f_tid]; bef += PS[512 + p * 32 + f_tid]; }
            PS[f_tid] = (tot + 255) & ~255; BASE[f_tid] = bef; }
        __syncthreads();
        if (f_tid == 0) { int o = 0; for (int e = 0; e < NEXP; ++e) { OFF[e] = o; o += PS[e]; } OFF[NEXP] = o; }
        __syncthreads();
        if (chunk == 0) {
            for (int t = f_tid; t < MAXTILE; t += 512) { const int s = t * 256; int e = 0;
#pragma unroll
                for (int i = 1; i < NEXP; ++i) if (s >= OFF[i]) e = i;
                mo[MO_TILEE + t] = e; }
            if (f_tid == 0) mo[MO_NTILE] = OFF[NEXP] >> 8;
        }
        const int n0 = chunk * 64;
        for (int t = F.wave; t < 64; t += NWAVES) {
            const int n = n0 + t, i = 2 * n; const int e0 = mo[MO_EID + i], e1 = mo[MO_EID + i + 1];
            const int s0 = OFF[e0] + BASE[e0] + mo[MO_LRANK + i], s1 = OFF[e1] + BASE[e1] + mo[MO_LRANK + i + 1]; const float rstd = ((const float*)mo)[MO_RSTD + n];
            if (f_lane == 0) { mo[MO_TOKSLOT + i] = s0; mo[MO_TOKSLOT + i + 1] = s1; }
            const GAS v4u* src = (const GAS v4u*)(XR + (size_t)n * DM) + f_lane; GAS v4u* d0 = (GAS v4u*)(AP + (size_t)s0 * DM) + f_lane; GAS v4u* d1 = (GAS v4u*)(AP + (size_t)s1 * DM) + f_lane;
#pragma unroll
            for (int q = 0; q < 4; ++q) { const v4u x = src[64 * q]; const GAS f32x4* gp = (const GAS f32x4*)g + 2 * (f_lane + 64 * q); const f32x4 g0 = gp[0], g1 = gp[1]; v4u o;
                o.x = cvtpk(bf_lo(x.x) * rstd * g0.x, bf_hi(x.x) * rstd * g0.y); o.y = cvtpk(bf_lo(x.y) * rstd * g0.z, bf_hi(x.y) * rstd * g0.w);
                o.z = cvtpk(bf_lo(x.z) * rstd * g1.x, bf_hi(x.z) * rstd * g1.y); o.w = cvtpk(bf_lo(x.w) * rstd * g1.z, bf_hi(x.w) * rstd * g1.w);
                d0[64 * q] = o; d1[64 * q] = o; }
        }
        __syncthreads();
    }
}

template <bool FINAL>
__device__ __forceinline__ void p10_combine(Frame& F, const float* g, float* out) {
    const int f_lane = lane_fresh(), f_tid = F.wave * 64 + f_lane;
    const int gw = F.vcu * NWAVES + F.wave, NGW = F.G * NWAVES, lane = f_lane;
    bf16* XR = (bf16*)(F.ws + WS_XR); const bf16* Y = (const bf16*)(F.ws + WS_Y); bf16* HN = (bf16*)(F.ws + WS_HN); const int* mo = (const int*)(F.ws + WS_MOE);
    for (int n = gw; n < NTOK; n += NGW) {
        const int s0 = mo[MO_TOKSLOT + 2 * n], s1 = mo[MO_TOKSLOT + 2 * n + 1]; const float w0 = ((const float*)mo)[MO_EW + 2 * n], w1 = ((const float*)mo)[MO_EW + 2 * n + 1];
        GAS v2u* xr = (GAS v2u*)(XR + (size_t)n * DM) + lane; const GAS v2u* y0 = (const GAS v2u*)(Y + (size_t)s0 * DM) + lane; const GAS v2u* y1 = (const GAS v2u*)(Y + (size_t)s1 * DM) + lane;
        f32x4 v[8]; float s = 0.f;
#pragma unroll
        for (int j = 0; j < 8; ++j) { const v2u xb = xr[64 * j]; const f32x4 x = {bf_lo(xb.x), bf_hi(xb.x), bf_lo(xb.y), bf_hi(xb.y)}; const v2u a = y0[64 * j], b = y1[64 * j];
            v[j].x = x.x + w0 * bf_lo(a.x) + w1 * bf_lo(b.x); v[j].y = x.y + w0 * bf_hi(a.x) + w1 * bf_hi(b.x); v[j].z = x.z + w0 * bf_lo(a.y) + w1 * bf_lo(b.y); v[j].w = x.w + w0 * bf_hi(a.y) + w1 * bf_hi(b.y);
            s += (v[j].x * v[j].x + v[j].y * v[j].y) + (v[j].z * v[j].z + v[j].w * v[j].w); }
        const float rstd = rsqrtf(wave_sum(s) * (1.f / DM) + EPS); const GAS f32x4* gr = (const GAS f32x4*)g + lane;
        if constexpr (FINAL) { GAS f32x4* o = (GAS f32x4*)(out + (size_t)n * DM) + lane;
#pragma unroll
            for (int j = 0; j < 8; ++j) { const f32x4 gg = gr[64 * j]; o[64 * j] = (f32x4){v[j].x * rstd * gg.x, v[j].y * rstd * gg.y, v[j].z * rstd * gg.z, v[j].w * rstd * gg.w}; } }
        else { GAS v2u* o8 = (GAS v2u*)(HN + (size_t)n * DM) + lane;
#pragma unroll
            for (int j = 0; j < 8; ++j) { const f32x4 gg = gr[64 * j]; { v2u xo; xo.x = cvtpk(v[j].x, v[j].y); xo.y = cvtpk(v[j].z, v[j].w); xr[64 * j] = xo; } v2u o; o.x = cvtpk(v[j].x * rstd * gg.x, v[j].y * rstd * gg.y); o.y = cvtpk(v[j].z * rstd * gg.z, v[j].w * rstd * gg.w); o8[64 * j] = o; } }
    }
}

__device__ __forceinline__ void p13_diff_combine(Frame& F, const In& in) {
    const int f_lane = lane_fresh(), f_tid = F.wave * 64 + f_lane;
    const int gw = F.vcu * NWAVES + F.wave, NGW = F.G * NWAVES, lane = f_lane;
    const bf16* OD = (const bf16*)(F.ws + WS_OD); bf16* ATT = (bf16*)(F.ws + WS_ATT);
    float a = in.p[18][lane] * in.p[19][lane] + in.p[18][64 + lane] * in.p[19][64 + lane], c = in.p[20][lane] * in.p[21][lane] + in.p[20][64 + lane] * in.p[21][64 + lane];
    const float lam = expf(wave_sum(a)) - expf(wave_sum(c)) + LAM_INIT;
    const f32x4 gg = *((const GAS f32x4*)in.p[22] + lane);
    for (int i = gw; i < NTOK * DH; i += NGW) {
        const int n = i >> 3, h = i & 7;
        const int b_ = n / SEQ, t_ = n - b_ * SEQ; const size_t ob = ((size_t)((b_ * 8 + h) * 2) * SEQ + t_) * 256;
        const v2u o0 = *((const GAS v2u*)(OD + ob) + lane), o1 = *((const GAS v2u*)(OD + ob + (size_t)SEQ * 256) + lane);
        const float v0 = bf_lo(o0.x) - lam * bf_lo(o1.x), v1 = bf_hi(o0.x) - lam * bf_hi(o1.x), v2 = bf_lo(o0.y) - lam * bf_lo(o1.y), v3 = bf_hi(o0.y) - lam * bf_hi(o1.y);
        const float r = rsqrtf(wave_sum((v0 * v0 + v1 * v1) + (v2 * v2 + v3 * v3)) * (1.f / 256.f) + EPS) * (1.f - LAM_INIT);
        v2u o; o.x = cvtpk(v0 * r * gg.x, v1 * r * gg.y); o.y = cvtpk(v2 * r * gg.z, v3 * r * gg.w);
        *((GAS v2u*)(ATT + (size_t)n * DM + h * 256) + lane) = o;
    }
}

constexpr float LOG2E = 1.4426950408889634f;
#ifndef MLA_NDV
#define MLA_NDV 4
#endif
struct MlaRef { __device__ __forceinline__ att::BlockRef operator()(unsigned char* ws, int L, int pass) const {
    const int x = L & 7, bh = L >> 3, b = bh >> 3, h = bh & 7, qb = pass ? 15 - x : x; const size_t r0 = (size_t)b * SEQ;
    att::BlockRef r; r.Q = (const bf16*)(ws + WS_Q) + ((size_t)bh * SEQ + qb * 256) * 192; r.K = (const bf16*)(ws + WS_KNV) + (size_t)(b * 16 + h) * SEQ * 128; r.K2 = (const bf16*)(ws + WS_KR) + r0 * 64;
    r.V = (const bf16*)(ws + WS_KNV) + (size_t)(b * 16 + 8 + h) * SEQ * 128; r.O = (bf16*)(ws + WS_CAT) + (r0 + qb * 256) * 2048 + 1024 + h * 128; r.P0 = qb * 256; r.sl2 = 0.f; return r;
} };
struct DiffRef { __device__ __forceinline__ att::BlockRef operator()(unsigned char* ws, int L, int pass) const {
    const int x = L & 7, vq = (L >> 3) & 3, bh = L >> 5, j = vq >> 1, vh = vq & 1, b = bh >> 3, h = bh & 7, qb = pass ? 15 - x : x;
    att::BlockRef r; r.Q = (const bf16*)(ws + WS_Q1) + ((size_t)(bh * 2 + j) * SEQ + qb * 256) * 128; r.K = (const bf16*)(ws + WS_K1) + (size_t)(bh * 2 + j) * SEQ * 128; r.K2 = nullptr;
    r.V = (const bf16*)(ws + WS_V1) + (size_t)bh * SEQ * 256 + vh * 128; r.O = (bf16*)(ws + WS_OD) + ((size_t)(bh * 2 + j) * SEQ + qb * 256) * 256 + vh * 128; r.P0 = qb * 256;
    r.sl2 = exp2f(-(float)(h + 1)) * LOG2E; (void)b; return r;
} };
template <int QP, int KP, int VP, int OP, bool ROPE, bool ALIBI, class RefFn, class ItemFn>
__device__ __forceinline__ void attn_phase(char* lds, unsigned char* ws, RefFn ref, ItemFn items, const int wid) {
    for (int i = 0;; ++i) { const int L = items(i); if (L < 0) break;
        for (int pass = 0; pass < 2; ++pass) { const att::BlockRef cur = ref(ws, L, pass); att::attn_block<QP, KP, VP, OP, ROPE, ALIBI>(cur, lds, wid); } }
}
struct DiffItems { int vcu, G; __device__ __forceinline__ int operator()(int i) const {
    if (G == 256) { if (i >= 4) return -1; const int xcd = vcu >> 5, w = vcu & 31; return ((xcd * 4 + i) * 4 + (w >> 3)) * 8 + (w & 7); }
    const int L = i * G + vcu; return L < 1024 ? L : -1; } };
struct MlaItems { int vcu, G, nvh; __device__ __forceinline__ int operator()(int i) const {
    const int tot = 256 * nvh;
    if (G == 256) { if (i >= nvh) return -1; const int xcd = vcu >> 5, w = vcu & 31;
        if (nvh == 2) return (((xcd * 4 + i * 2 + (w >> 4)) * 2) + ((w >> 3) & 1)) * 8 + (w & 7);
        return (xcd * 4 + (w >> 3)) * 8 + (w & 7); }
    const int L = i * G + vcu; return L < tot ? L : -1; } };

#ifndef MK_N_LAUNCHES
#define MK_N_LAUNCHES 1
#endif
constexpr int N_PHASES = 20;
constexpr int N_LAUNCHES = MK_N_LAUNCHES;
struct Args { In in; float* out; unsigned char* ws; int ph_lo, ph_hi, li, pad; };
__global__ void __launch_bounds__(NWAVES * 64, 2) mega_fwd(Args args) {
    extern __shared__ __attribute__((aligned(16))) unsigned char lds[];
    Frame F;
    F.lds = (LAS unsigned char*)lds; F.MISC = (volatile LAS unsigned*)(F.lds + MISC_OFF);
    F.wave = __builtin_amdgcn_readfirstlane((int)threadIdx.x >> 6);
    F.G = gridDim.x; { const int bx = blockIdx.x; F.vcu = (F.G % 8 == 0) ? (bx % 8) * (F.G / 8) + bx / 8 : bx; }
    F.ws = args.ws; F.ctl = (gu32*)(args.ws + WS_CTL);
    unsigned char* ws = args.ws; const In& in = args.in;
    for (int u = threadIdx.x; u < (LDS_BYTES - LDSCTL_OFF) / 4; u += NWAVES * 64) ((LAS unsigned*)(F.lds + LDSCTL_OFF))[u] = 0u;
    __syncthreads();
    XcdBarrier bar; bar.bar = (unsigned*)(F.ctl + CW_BAR); bar.x = 0; bar.st = nullptr;
    if (N_LAUNCHES == 1) bar = xcd_barrier_post((unsigned*)(F.ctl + CW_BAR), F.MISC + 8);
#define GRID_BAR() do { if (N_LAUNCHES == 1) xcd_barrier(bar, F.wave == 0 && lane_fresh() == 0); } while (0)
    const int lo = args.ph_lo, hi = args.ph_hi;
#ifndef PHASE_MASK
#define PHASE_MASK 0xFFFFFu
#endif
#ifndef DUP_MASK
#define DUP_MASK 0u
#endif
#define DUP_(k) ((((DUP_MASK) >> (k)) & 1u) != 0u)
#define IN_(k) ((((PHASE_MASK) >> (k)) & 1u) && lo <= (k) && (k) < hi)
#define SEAM(k) do { if (IN_(k) && IN_((k) + 1)) GRID_BAR(); } while (0)
    const float C2_MLA = 0.07216878364870322f * LOG2E, C2_DIFF = 0.08838834764831845f * LOG2E;
    typedef pg8::bf16_t pb;

    if (IN_(0)) { p0_prologue(F, in); } if (DUP_(0) && IN_(0)) { GRID_BAR(); { p0_prologue(F, in); } } SEAM(0);
    if (IN_(1)) { pg8::Gemm g{(const pb*)(ws + WS_HN), (const pb*)(ws + WS_WIN), NTOK, 4096, DM}; pg8::StaticOrder S; S.init(NTOK, 4096, F.G, (int)blockIdx.x);
        pg8::EpiBf16S E{(pb*)(ws + WS_ZIN), 4096, 0x7fffffff, 1 << 20, 0, 1.f};
        pg8::gemm_phase<pg8::EpiBf16S, pg8::StaticOrder, true, true>(F.lds + RING_OFF, g, S, E, F.wave); } if (DUP_(1) && IN_(1)) { GRID_BAR(); { pg8::Gemm g{(const pb*)(ws + WS_HN), (const pb*)(ws + WS_WIN), NTOK, 4096, DM}; pg8::StaticOrder S; S.init(NTOK, 4096, F.G, (int)blockIdx.x);
        pg8::EpiBf16S E{(pb*)(ws + WS_ZIN), 4096, 0x7fffffff, 1 << 20, 0, 1.f};
        pg8::gemm_phase<pg8::EpiBf16S, pg8::StaticOrder, true, true>(F.lds + RING_OFF, g, S, E, F.wave); } } SEAM(1);
    if (IN_(2)) { p2_even_local(F, in); } if (DUP_(2) && IN_(2)) { GRID_BAR(); { p2_even_local(F, in); } } SEAM(2);
    if (IN_(3)) {
        { pg8::Gemm g{(const pb*)(ws + WS_QL), (const pb*)(ws + WS_WUQ), NTOK, 1536, QRANK}; pg8::StaticOrder S; S.init(NTOK, 1536, F.G, (int)blockIdx.x);
          pg8::EpiQRope E{(pb*)(ws + WS_Q), 1536, (const float*)(ws + WS_ROPE), SEQ - 1, C2_MLA};
          pg8::gemm_phase<pg8::EpiQRope, pg8::StaticOrder, true, true>(F.lds + RING_OFF, g, S, E, F.wave); }
        { pg8::Gemm g{(const pb*)(ws + WS_KVL), (const pb*)(ws + WS_WUKV), NTOK, 2048, KVRANK}; pg8::StaticOrder S; S.init(NTOK, 2048, F.G, (int)blockIdx.x);
          pg8::EpiBf16S E{(pb*)(ws + WS_KNV), 2048, 0x7fffffff, 1 << 20, 0, 1.f, 128, 128, SEQ};
          pg8::gemm_phase<pg8::EpiBf16S, pg8::StaticOrder, true, true>(F.lds + RING_OFF, g, S, E, F.wave); } } if (DUP_(3) && IN_(3)) { GRID_BAR(); {
        { pg8::Gemm g{(const pb*)(ws + WS_QL), (const pb*)(ws + WS_WUQ), NTOK, 1536, QRANK}; pg8::StaticOrder S; S.init(NTOK, 1536, F.G, (int)blockIdx.x);
          pg8::EpiQRope E{(pb*)(ws + WS_Q), 1536, (const float*)(ws + WS_ROPE), SEQ - 1, C2_MLA};
          pg8::gemm_phase<pg8::EpiQRope, pg8::StaticOrder, true, true>(F.lds + RING_OFF, g, S, E, F.wave); }
        { pg8::Gemm g{(const pb*)(ws + WS_KVL), (const pb*)(ws + WS_WUKV), NTOK, 2048, KVRANK}; pg8::StaticOrder S; S.init(NTOK, 2048, F.G, (int)blockIdx.x);
          pg8::EpiBf16S E{(pb*)(ws + WS_KNV), 2048, 0x7fffffff, 1 << 20, 0, 1.f, 128, 128, SEQ};
          pg8::gemm_phase<pg8::EpiBf16S, pg8::StaticOrder, true, true>(F.lds + RING_OFF, g, S, E, F.wave); } } } SEAM(3);
    if (IN_(4)) { attn_phase<192, 128, 128, 2048, true, false>((char*)lds + RING_OFF, ws, MlaRef(), MlaItems{F.vcu, F.G, 4 / MLA_NDV}, F.wave); }
    if (DUP_(4) && IN_(4)) { GRID_BAR(); attn_phase<192, 128, 128, 2048, true, false>((char*)lds + RING_OFF, ws, MlaRef(), MlaItems{F.vcu, F.G, 4 / MLA_NDV}, F.wave); } SEAM(4);
    if (IN_(5)) { pg8::Gemm g{(const pb*)(ws + WS_CAT), (const pb*)(ws + WS_WO0), NTOK, DM, DM}; pg8::StaticOrder S; S.init(NTOK, DM, F.G, (int)blockIdx.x);
        pg8::EpiResBf16<true> E{in.p[0], (pb*)(ws + WS_XR), DM};
        pg8::gemm_phase<pg8::EpiResBf16<true>, pg8::StaticOrder, true, true>(F.lds + RING_OFF, g, S, E, F.wave); } if (DUP_(5) && IN_(5)) { GRID_BAR(); { pg8::Gemm g{(const pb*)(ws + WS_CAT), (const pb*)(ws + WS_WO0), NTOK, DM, DM}; pg8::StaticOrder S; S.init(NTOK, DM, F.G, (int)blockIdx.x);
        pg8::EpiResBf16<true> E{in.p[0], (pb*)(ws + WS_XR), DM};
        pg8::gemm_phase<pg8::EpiResBf16<true>, pg8::StaticOrder, true, true>(F.lds + RING_OFF, g, S, E, F.wave); } } SEAM(5);
    if (IN_(6)) { p6_route(F, in.p[9], in.p[11], in.p[13], ws + WS_WR0); } if (DUP_(6) && IN_(6)) { GRID_BAR(); { p6_route(F, in.p[9], in.p[11], in.p[13], ws + WS_WR0); } } SEAM(6);
    if (IN_(7)) { p7_dispatch(F, in.p[9]); } if (DUP_(7) && IN_(7)) { GRID_BAR(); { p7_dispatch(F, in.p[9]); } } SEAM(7);
    if (IN_(8)) { const int* mo = (const int*)(ws + WS_MOE); pg8::Gemm g{(const pb*)(ws + WS_AP), (const pb*)(ws + WS_WUP0), 0, 0, DM}; pg8::GroupedOrder S; S.init(mo + MO_TILEE, mo[MO_NTILE], 4, F.G, (int)blockIdx.x);
        pg8::EpiSwiGLU E{(pb*)(ws + WS_HS)};
        pg8::gemm_phase<pg8::EpiSwiGLU, pg8::GroupedOrder, true, true>(F.lds + RING_OFF, g, S, E, F.wave); } if (DUP_(8) && IN_(8)) { GRID_BAR(); { const int* mo = (const int*)(ws + WS_MOE); pg8::Gemm g{(const pb*)(ws + WS_AP), (const pb*)(ws + WS_WUP0), 0, 0, DM}; pg8::GroupedOrder S; S.init(mo + MO_TILEE, mo[MO_NTILE], 4, F.G, (int)blockIdx.x);
        pg8::EpiSwiGLU E{(pb*)(ws + WS_HS)};
        pg8::gemm_phase<pg8::EpiSwiGLU, pg8::GroupedOrder, true, true>(F.lds + RING_OFF, g, S, E, F.wave); } } SEAM(8);
    if (IN_(9)) { const int* mo = (const int*)(ws + WS_MOE); pg8::Gemm g{(const pb*)(ws + WS_HS), (const pb*)(ws + WS_WDN0), 0, 0, EFF}; pg8::GroupedOrder S; S.init(mo + MO_TILEE, mo[MO_NTILE], 8, F.G, (int)blockIdx.x);
        pg8::EpiBf16S E{(pb*)(ws + WS_Y), DM, 7, 1 << 20, 0, 1.f};
        pg8::gemm_phase<pg8::EpiBf16S, pg8::GroupedOrder, true, true>(F.lds + RING_OFF, g, S, E, F.wave); } if (DUP_(9) && IN_(9)) { GRID_BAR(); { const int* mo = (const int*)(ws + WS_MOE); pg8::Gemm g{(const pb*)(ws + WS_HS), (const pb*)(ws + WS_WDN0), 0, 0, EFF}; pg8::GroupedOrder S; S.init(mo + MO_TILEE, mo[MO_NTILE], 8, F.G, (int)blockIdx.x);
        pg8::EpiBf16S E{(pb*)(ws + WS_Y), DM, 7, 1 << 20, 0, 1.f};
        pg8::gemm_phase<pg8::EpiBf16S, pg8::GroupedOrder, true, true>(F.lds + RING_OFF, g, S, E, F.wave); } } SEAM(9);
    if (IN_(10)) { p10_combine<false>(F, in.p[16], nullptr); } SEAM(10);
    if (IN_(11)) { pg8::Gemm g{(const pb*)(ws + WS_HN), (const pb*)(ws + WS_WQKV), NTOK, 6144, DM}; pg8::StaticOrder S; S.init(NTOK, 6144, F.G, (int)blockIdx.x);
        pg8::EpiBf16S E{(pb*)(ws + WS_Q1), DM, 0x7fffffff, 8, (size_t)(WS_K1 - WS_Q1) / 2, C2_DIFF, 128, 256, SEQ};
        pg8::gemm_phase<pg8::EpiBf16S, pg8::StaticOrder, true, true>(F.lds + RING_OFF, g, S, E, F.wave); } if (DUP_(11) && IN_(11)) { GRID_BAR(); { pg8::Gemm g{(const pb*)(ws + WS_HN), (const pb*)(ws + WS_WQKV), NTOK, 6144, DM}; pg8::StaticOrder S; S.init(NTOK, 6144, F.G, (int)blockIdx.x);
        pg8::EpiBf16S E{(pb*)(ws + WS_Q1), DM, 0x7fffffff, 8, (size_t)(WS_K1 - WS_Q1) / 2, C2_DIFF, 128, 256, SEQ};
        pg8::gemm_phase<pg8::EpiBf16S, pg8::StaticOrder, true, true>(F.lds + RING_OFF, g, S, E, F.wave); } } SEAM(11);
    if (IN_(12)) { attn_phase<128, 128, 256, 256, false, true>((char*)lds + RING_OFF, ws, DiffRef(), DiffItems{F.vcu, F.G}, F.wave); }
    if (DUP_(12) && IN_(12)) { GRID_BAR(); attn_phase<128, 128, 256, 256, false, true>((char*)lds + RING_OFF, ws, DiffRef(), DiffItems{F.vcu, F.G}, F.wave); } SEAM(12);
    if (IN_(13)) { p13_diff_combine(F, in); } if (DUP_(13) && IN_(13)) { GRID_BAR(); { p13_diff_combine(F, in); } } SEAM(13);
    if (IN_(14)) { pg8::Gemm g{(const pb*)(ws + WS_ATT), (const pb*)(ws + WS_WO1), NTOK, DM, DM}; pg8::StaticOrder S; S.init(NTOK, DM, F.G, (int)blockIdx.x);
        pg8::EpiResBf16<false> E{(const void*)(ws + WS_XR), (pb*)(ws + WS_XR), DM};
        pg8::gemm_phase<pg8::EpiResBf16<false>, pg8::StaticOrder, true, true>(F.lds + RING_OFF, g, S, E, F.wave); } SEAM(14);
    if (IN_(15)) { p6_route(F, in.p[24], in.p[26], in.p[28], ws + WS_WR1); } if (DUP_(15) && IN_(15)) { GRID_BAR(); { p6_route(F, in.p[24], in.p[26], in.p[28], ws + WS_WR1); } } SEAM(15);
    if (IN_(16)) { p7_dispatch(F, in.p[24]); } if (DUP_(16) && IN_(16)) { GRID_BAR(); { p7_dispatch(F, in.p[24]); } } SEAM(16);
    if (IN_(17)) { const int* mo = (const int*)(ws + WS_MOE); pg8::Gemm g{(const pb*)(ws + WS_AP), (const pb*)(ws + WS_WUP1), 0, 0, DM}; pg8::GroupedOrder S; S.init(mo + MO_TILEE, mo[MO_NTILE], 4, F.G, (int)blockIdx.x);
        pg8::EpiSwiGLU E{(pb*)(ws + WS_HS)};
        pg8::gemm_phase<pg8::EpiSwiGLU, pg8::GroupedOrder, true, true>(F.lds + RING_OFF, g, S, E, F.wave); } if (DUP_(17) && IN_(17)) { GRID_BAR(); { const int* mo = (const int*)(ws + WS_MOE); pg8::Gemm g{(const pb*)(ws + WS_AP), (const pb*)(ws + WS_WUP1), 0, 0, DM}; pg8::GroupedOrder S; S.init(mo + MO_TILEE, mo[MO_NTILE], 4, F.G, (int)blockIdx.x);
        pg8::EpiSwiGLU E{(pb*)(ws + WS_HS)};
        pg8::gemm_phase<pg8::EpiSwiGLU, pg8::GroupedOrder, true, true>(F.lds + RING_OFF, g, S, E, F.wave); } } SEAM(17);
    if (IN_(18)) { const int* mo = (const int*)(ws + WS_MOE); pg8::Gemm g{(const pb*)(ws + WS_HS), (const pb*)(ws + WS_WDN1), 0, 0, EFF}; pg8::GroupedOrder S; S.init(mo + MO_TILEE, mo[MO_NTILE], 8, F.G, (int)blockIdx.x);
        pg8::EpiBf16S E{(pb*)(ws + WS_Y), DM, 7, 1 << 20, 0, 1.f};
        pg8::gemm_phase<pg8::EpiBf16S, pg8::GroupedOrder, true, true>(F.lds + RING_OFF, g, S, E, F.wave); } if (DUP_(18) && IN_(18)) { GRID_BAR(); { const int* mo = (const int*)(ws + WS_MOE); pg8::Gemm g{(const pb*)(ws + WS_HS), (const pb*)(ws + WS_WDN1), 0, 0, EFF}; pg8::GroupedOrder S; S.init(mo + MO_TILEE, mo[MO_NTILE], 8, F.G, (int)blockIdx.x);
        pg8::EpiBf16S E{(pb*)(ws + WS_Y), DM, 7, 1 << 20, 0, 1.f};
        pg8::gemm_phase<pg8::EpiBf16S, pg8::GroupedOrder, true, true>(F.lds + RING_OFF, g, S, E, F.wave); } } SEAM(18);
    if (IN_(19)) { p10_combine<true>(F, in.p[31], args.out); }
#undef IN_
#undef SEAM
#undef GRID_BAR
}

extern "C" void kernel_launch(void* const* d_in, const int* in_sizes, int n_in, void* d_out, int out_size, void* d_ws, size_t ws_size, hipStream_t stream) {
    static int grid = 0;
    if (grid == 0) {
        if (n_in != 32 || in_sizes[0] != NTOK * DM || out_size != NTOK * DM || ws_size < WS_END) { fprintf(stderr, "kernel_launch: unexpected shapes: n_in %d in0 %d out %d ws %zu; nothing launched\n", n_in, n_in > 0 ? in_sizes[0] : -1, out_size, ws_size); grid = -1; return; }
        int dev = 0, cus = 0, per_cu = 0;
        if (hipGetDevice(&dev) != hipSuccess || hipDeviceGetAttribute(&cus, hipDeviceAttributeMultiprocessorCount, dev) != hipSuccess) { fprintf(stderr, "kernel_launch: device query failed\n"); grid = -1; return; }
        if (hipFuncSetAttribute((const void*)mega_fwd, hipFuncAttributeMaxDynamicSharedMemorySize, LDS_BYTES) != hipSuccess) { fprintf(stderr, "kernel_launch: hipFuncSetAttribute failed\n"); grid = -1; return; }
        if (hipOccupancyMaxActiveBlocksPerMultiprocessor(&per_cu, (const void*)mega_fwd, NWAVES * 64, LDS_BYTES) != hipSuccess || per_cu < 1)
            fprintf(stderr, "kernel_launch: note: occupancy query reports %d workgroups per CU\n", per_cu);
        (void)hipGetLastError();
        grid = cus;
    }
    if (grid < 0) return;
    if (hipMemsetAsync((char*)d_ws + WS_CTL, 0, CTL_ZERO_BYTES, stream) != hipSuccess) { fprintf(stderr, "kernel_launch: memset failed\n"); return; }
    Args a{};
    for (int i = 0; i < 32; ++i) a.in.p[i] = (const float*)d_in[i];
    a.out = (float*)d_out; a.ws = (unsigned char*)d_ws;
    for (int li = 0; li < N_LAUNCHES; ++li) {
        a.ph_lo = (N_LAUNCHES == 1) ? 0 : li; a.ph_hi = (N_LAUNCHES == 1) ? N_PHASES : li + 1; a.li = li;
        hipLaunchKernelGGL(mega_fwd, dim3(grid), dim3(NWAVES * 64), LDS_BYTES, stream, a);
        const hipError_t le = hipPeekAtLastError();
        if (le != hipSuccess) { fprintf(stderr, "kernel_launch: launch %d failed: %s\n", li, hipGetErrorName(le)); break; }
    }
}
```
